# Optimizing an MI355X kernel written in HIP

```python
import math
import jax, jax.numpy as jnp
from jax import lax
import numpy as np

D_MODEL = 2048
BATCH = 16
SEQ = 2048
DEPTH = 4
DEC_BATCH = 4
DEC_SEQ = 4096
PAST_LEN = 128

N_HEADS = 8
HEAD_DIM = 64
V_DIM = 2 * HEAD_DIM
QK_WIDTH = N_HEADS * 2 * HEAD_DIM
ATTN_WIDTH = N_HEADS * V_DIM
ROT_DIM = HEAD_DIM // 4
ROPE_THETA = 500000.0
Q_BLOCK = 128
SSM_WIDTH = D_MODEL // 4
SSM_GROUP = 16
SSM_GROUPS = SSM_WIDTH // SSM_GROUP
SSM_STATE = 64
DT_MIN = 0.001
DT_MAX = 0.1
POOL_WIDTH = D_MODEL // 4
POOL_WINDOWS = (2, 4, 8, 16)
POOL_GROUP = POOL_WIDTH // len(POOL_WINDOWS)
MIX_WIDTH = ATTN_WIDTH + SSM_WIDTH + POOL_WIDTH
IN_WIDTH = 2 * QK_WIDTH + ATTN_WIDTH + SSM_WIDTH + POOL_WIDTH
D_FF = 4 * D_MODEL
EPS = 1e-6

kernel_name = "hybrid_bidir_parallel_encoder"


def rmsnorm(x, g):
    xf = x.astype(jnp.float32)
    y = xf * lax.rsqrt(jnp.mean(xf * xf, axis=-1, keepdims=True) + EPS)
    return (y * g.astype(jnp.float32)).astype(x.dtype)


def partial_rope(x):
    L = x.shape[1]
    half = ROT_DIM // 2
    inv = ROPE_THETA ** (-jnp.arange(0, ROT_DIM, 2, dtype=jnp.float32) / ROT_DIM)
    ang = jnp.arange(L, dtype=jnp.float32)[:, None] * inv[None, :]
    cos = jnp.cos(ang)[None, :, None, None, :].astype(x.dtype)
    sin = jnp.sin(ang)[None, :, None, None, :].astype(x.dtype)
    x1 = x[..., :half]
    x2 = x[..., half:ROT_DIM]
    return jnp.concatenate([x1 * cos - x2 * sin, x2 * cos + x1 * sin, x[..., ROT_DIM:]], axis=-1)


def diff_attention(q, k, v, lam, subln_g, lam_init):
    B, L = q.shape[0], q.shape[1]
    nb = L // Q_BLOCK
    qb = jnp.moveaxis(q.reshape(B, nb, Q_BLOCK, N_HEADS, 2, HEAD_DIM), 1, 0)
    scale = HEAD_DIM ** -0.5

    def block(qblk):
        s = jnp.einsum('bqhcd,bkhcd->bhcqk', qblk, k).astype(jnp.float32) * scale
        p = jax.nn.softmax(s, axis=-1)
        w = (p[:, :, 0] - lam * p[:, :, 1]).astype(v.dtype)
        return jnp.einsum('bhqk,bkhd->bqhd', w, v)

    o = lax.map(block, qb)
    o = jnp.moveaxis(o, 0, 1).reshape(B, L, N_HEADS, V_DIM)
    o = rmsnorm(o, subln_g) * (1.0 - lam_init)
    return o.reshape(B, L, ATTN_WIDTH)


def _ssm_combine(e1, e2):
    a1r, a1i, b1r, b1i = e1
    a2r, a2i, b2r, b2i = e2
    return (a2r * a1r - a2i * a1i,
            a2r * a1i + a2i * a1r,
            a2r * b1r - a2i * b1i + b2r,
            a2r * b1i + a2i * b1r + b2i)


def ssm_direction(uf, lam_re, lam_im, log_dt, b_re, b_im, c_re, c_im):
    L = uf.shape[1]
    lr = lam_re.astype(jnp.float32)
    li = lam_im.astype(jnp.float32)
    dt = jnp.exp(log_dt.astype(jnp.float32))[:, None]
    mag = jnp.exp(lr * dt)
    ar = mag * jnp.cos(li * dt)
    ai = mag * jnp.sin(li * dt)
    den = lr * lr + li * li
    nr = ar - 1.0
    cr = (nr * lr + ai * li) / den
    ci = (ai * lr - nr * li) / den
    br = b_re.astype(jnp.float32)
    bi = b_im.astype(jnp.float32)
    bbr = cr[..., None] * br - ci[..., None] * bi
    bbi = cr[..., None] * bi + ci[..., None] * br
    xr = jnp.einsum('blgh,gph->blgp', uf, bbr)
    xi = jnp.einsum('blgh,gph->blgp', uf, bbi)
    shp = (1, L) + ar.shape
    a_r = jnp.broadcast_to(ar[None, None], shp)
    a_i = jnp.broadcast_to(ai[None, None], shp)
    _, _, sr, si = lax.associative_scan(_ssm_combine, (a_r, a_i, xr, xi), axis=1)
    return (jnp.einsum('blgp,ghp->blgh', sr, c_re.astype(jnp.float32))
            - jnp.einsum('blgp,ghp->blgh', si, c_im.astype(jnp.float32)))


def s5_mixer(u, lam_re, lam_im, log_dt, b_re, b_im, c_re, c_im, d, glu_w, glu_b):
    B, L, _ = u.shape
    uf = u.astype(jnp.float32).reshape(B, L, SSM_GROUPS, SSM_GROUP)
    y_f = ssm_direction(uf, lam_re[0], lam_im[0], log_dt[0], b_re[0], b_im[0], c_re[0], c_im[0])
    y_b = jnp.flip(ssm_direction(jnp.flip(uf, axis=1), lam_re[1], lam_im[1], log_dt[1],
                                 b_re[1], b_im[1], c_re[1], c_im[1]), axis=1)
    y = (y_f + y_b).reshape(B, L, SSM_WIDTH) + d.astype(jnp.float32) * uf.reshape(B, L, SSM_WIDTH)
    z = jax.nn.gelu(y)
    out = z * jax.nn.sigmoid(z @ glu_w.astype(jnp.float32) + glu_b.astype(jnp.float32))
    return out.astype(u.dtype)


def pool_mixer(u, pool_w, pool_scale):
    B, L, _ = u.shape
    uf = u.astype(jnp.float32).reshape(B, L, len(POOL_WINDOWS), POOL_GROUP)
    cs = jnp.concatenate([jnp.zeros((B, 1) + uf.shape[2:], jnp.float32),
                          jnp.cumsum(uf, axis=1)], axis=1)
    t = jnp.arange(L)
    means = []
    for gi, w in enumerate(POOL_WINDOWS):
        lo, hi = w // 2, w // 2 - 1
        end = jnp.clip(t + hi + 1, 0, L)
        start = jnp.clip(t - lo, 0, L)
        s = cs[:, end, gi] - cs[:, start, gi]
        cnt = (end - start).astype(jnp.float32)
        means.append(s / cnt[None, :, None])
    pooled = jnp.stack(means, axis=2) - uf
    out = jnp.einsum('blgc,gcd->blgd', pooled, pool_w.astype(jnp.float32))
    out = out.reshape(B, L, POOL_WIDTH) * pool_scale.astype(jnp.float32)
    return out.astype(u.dtype)


def trunk(x, g_mix, w_in, lam_q1, lam_k1, lam_q2, lam_k2, attn_subln,
          ssm_lam_re, ssm_lam_im, ssm_log_dt, ssm_b_re, ssm_b_im, ssm_c_re, ssm_c_im,
          ssm_d, glu_w, glu_b, pool_w, pool_scale, w_out, g_mlp, w_up, w_down, g_final):
    B, L, _ = x.shape
    for l in range(DEPTH):
        h = rmsnorm(x, g_mix[l])
        proj = h @ w_in[l]
        o0 = QK_WIDTH
        o1 = o0 + QK_WIDTH
        o2 = o1 + ATTN_WIDTH
        o3 = o2 + SSM_WIDTH
        q = partial_rope(proj[..., :o0].reshape(B, L, N_HEADS, 2, HEAD_DIM))
        k = partial_rope(proj[..., o0:o1].reshape(B, L, N_HEADS, 2, HEAD_DIM))
        v = proj[..., o1:o2].reshape(B, L, N_HEADS, V_DIM)
        u_s = proj[..., o2:o3]
        u_p = proj[..., o3:]
        lam_init = 0.8 - 0.6 * math.exp(-0.3 * l)
        lam = (jnp.exp(jnp.sum(lam_q1[l].astype(jnp.float32) * lam_k1[l].astype(jnp.float32)))
               - jnp.exp(jnp.sum(lam_q2[l].astype(jnp.float32) * lam_k2[l].astype(jnp.float32)))
               + lam_init)
        a_out = diff_attention(q, k, v, lam, attn_subln[l], lam_init)
        s_out = s5_mixer(u_s, ssm_lam_re[l], ssm_lam_im[l], ssm_log_dt[l], ssm_b_re[l], ssm_b_im[l],
                         ssm_c_re[l], ssm_c_im[l], ssm_d[l], glu_w[l], glu_b[l])
        p_out = pool_mixer(u_p, pool_w[l], pool_scale[l])
        mixed = jnp.concatenate([a_out, s_out, p_out], axis=-1)
        x = x + mixed @ w_out[l]
        h2 = rmsnorm(x, g_mlp[l])
        x = x + jnp.square(jax.nn.relu(h2 @ w_up[l])) @ w_down[l]
    return rmsnorm(x, g_final)


def setup_inputs(seed: int = 0) -> dict:
    key = jax.random.key(seed)
    ks = jax.random.split(key, 26)
    f32 = jnp.float32

    def nrm(k, shape, scale):
        return jax.random.normal(k, shape, f32) * scale

    G, P, Hc = SSM_GROUPS, SSM_STATE, SSM_GROUP
    n = jnp.arange(P, dtype=f32)
    return {
        "x_prompt": nrm(ks[0], (BATCH, SEQ, D_MODEL), 1.0),
        "x_sample": nrm(ks[1], (DEC_BATCH, DEC_SEQ, D_MODEL), 1.0),
        "g_mix": 1.0 + nrm(ks[2], (DEPTH, D_MODEL), 0.01),
        "w_in": nrm(ks[3], (DEPTH, D_MODEL, IN_WIDTH), D_MODEL ** -0.5),
        "lam_q1": nrm(ks[4], (DEPTH, HEAD_DIM), 0.1),
        "lam_k1": nrm(ks[5], (DEPTH, HEAD_DIM), 0.1),
        "lam_q2": nrm(ks[6], (DEPTH, HEAD_DIM), 0.1),
        "lam_k2": nrm(ks[7], (DEPTH, HEAD_DIM), 0.1),
        "attn_subln": 1.0 + nrm(ks[8], (DEPTH, V_DIM), 0.01),
        "ssm_lam_re": -0.5 + nrm(ks[9], (DEPTH, 2, G, P), 0.01),
        "ssm_lam_im": math.pi * n + nrm(ks[10], (DEPTH, 2, G, P), 0.01),
        "ssm_log_dt": jax.random.uniform(ks[11], (DEPTH, 2, G), f32,
                                         math.log(DT_MIN), math.log(DT_MAX)),
        "ssm_b_re": nrm(ks[12], (DEPTH, 2, G, P, Hc), (2 * Hc) ** -0.5),
        "ssm_b_im": nrm(ks[13], (DEPTH, 2, G, P, Hc), (2 * Hc) ** -0.5),
        "ssm_c_re": nrm(ks[14], (DEPTH, 2, G, Hc, P), P ** -0.5),
        "ssm_c_im": nrm(ks[15], (DEPTH, 2, G, Hc, P), P ** -0.5),
        "ssm_d": nrm(ks[16], (DEPTH, SSM_WIDTH), 1.0),
        "glu_w": nrm(ks[17], (DEPTH, SSM_WIDTH, SSM_WIDTH), SSM_WIDTH ** -0.5),
        "glu_b": nrm(ks[18], (DEPTH, SSM_WIDTH), 0.01),
        "pool_w": nrm(ks[19], (DEPTH, len(POOL_WINDOWS), POOL_GROUP, POOL_GROUP), POOL_GROUP ** -0.5),
        "pool_scale": 1.0 + nrm(ks[20], (DEPTH, POOL_WIDTH), 0.02),
        "w_out": nrm(ks[21], (DEPTH, MIX_WIDTH, D_MODEL), MIX_WIDTH ** -0.5),
        "g_mlp": 1.0 + nrm(ks[22], (DEPTH, D_MODEL), 0.01),
        "w_up": nrm(ks[23], (DEPTH, D_MODEL, D_FF), D_MODEL ** -0.5),
        "w_down": nrm(ks[24], (DEPTH, D_FF, D_MODEL), D_FF ** -0.5),
        "g_final": 1.0 + nrm(ks[25], (D_MODEL,), 0.01),
    }


def reference(x_prompt, x_sample, g_mix, w_in, lam_q1, lam_k1, lam_q2, lam_k2, attn_subln,
              ssm_lam_re, ssm_lam_im, ssm_log_dt, ssm_b_re, ssm_b_im, ssm_c_re, ssm_c_im,
              ssm_d, glu_w, glu_b, pool_w, pool_scale, w_out, g_mlp, w_up, w_down, g_final):
    y_prompt = trunk(x_prompt, g_mix, w_in, lam_q1, lam_k1, lam_q2, lam_k2, attn_subln,
                     ssm_lam_re, ssm_lam_im, ssm_log_dt, ssm_b_re, ssm_b_im, ssm_c_re, ssm_c_im,
                     ssm_d, glu_w, glu_b, pool_w, pool_scale, w_out, g_mlp, w_up, w_down, g_final)
    y_sample = trunk(x_sample, g_mix, w_in, lam_q1, lam_k1, lam_q2, lam_k2, attn_subln,
                     ssm_lam_re, ssm_lam_im, ssm_log_dt, ssm_b_re, ssm_b_im, ssm_c_re, ssm_c_im,
                     ssm_d, glu_w, glu_b, pool_w, pool_scale, w_out, g_mlp, w_up, w_down, g_final)
    return (y_prompt, y_sample)
```

```cpp
#include <hip/hip_runtime.h>
#include <hip/hip_bf16.h>
#include <cstdio>
#include <cstdint>
#include <cmath>
constexpr int DM = 2048, NTOK = 49152, NPROMPT = 32768, NLAYER = 4, DFF = 8192;
constexpr int CH_T = 16, NCHUNK = NTOK / CH_T  , NGRP = 32;
constexpr float QSCALE = 0.125f * 1.4426950408889634f;
constexpr float RMS_EPS = 1e-6f;

namespace pg8 {
#define PG8_LAS __attribute__((address_space(3)))
typedef unsigned short bf16_t;
typedef short bf16x8 __attribute__((ext_vector_type(8)));
typedef float f32x4 __attribute__((ext_vector_type(4)));
typedef unsigned u32x4 __attribute__((ext_vector_type(4)));
constexpr int BM = 256, BK = 64, HALF = 128, HTB = HALF * BK * 2  , STAGE_BYTES = 8 * HTB, NXCD = 8, WGM = 8;

__device__ __forceinline__ void glds_saddr(const void* sbase, unsigned voff, unsigned lds_addr) {
    asm volatile("s_mov_b32 m0, %2\n\ts_nop 3\n\tglobal_load_lds_dwordx4 %0, %1" :: "v"(voff), "s"(sbase), "s"(lds_addr) : "memory");
}
__host__ __device__ __forceinline__ int lds_byte(int r, int c) { const int st = (r >> 4) * 2 + (c >> 5), rr = r & 15, cc = c & 31, ob = rr * 64 + cc * 2; return st * 1024 + (ob ^ (((ob >> 9) & 1) << 5)); }
__host__ __device__ __forceinline__ void stage_rc(int b, int& R, int& C) { const int st = b / 1024, sb = b % 1024, swz = sb ^ (((sb >> 9) & 1) << 5); R = (st >> 1) * 16 + swz / 64; C = (st & 1) * 32 + (swz % 64) / 2; }
__host__ __device__ __forceinline__ int perm32(int rho) { const int n = rho >> 4, i = rho & 15; return 8 * (i >> 2) + 4 * n + (i & 3); }

struct Unit { int pm, pn; };
struct Gemm { const bf16_t* A; const bf16_t* Bt; int M, N, K; };

struct StaticOrder {
    int nM, nN, nwg, G, c;
    __host__ __device__ void init(int M, int N, int G_, int c_) { nM = M / BM; nN = N / BM; nwg = nM * nN; G = G_; c = c_; }
    __host__ __device__ bool next(int i, Unit& u) const {
        const long L = (long)i * G + c; if (L >= nwg) return false;
        int wgid = (int)L; { const int q = nwg / NXCD, r = nwg % NXCD, xcd = wgid % NXCD, off = wgid / NXCD; wgid = (xcd < r ? xcd * (q + 1) : r * (q + 1) + (xcd - r) * q) + off; }
        const int nig = WGM * nN, gid = wgid / nig, fm = gid * WGM, gsz = (nM - fm) < WGM ? (nM - fm) : WGM;
        u.pm = fm + ((wgid % nig) % gsz); u.pn = (wgid % nig) / gsz; return true;
    }
    __device__ __forceinline__ void a_ready(const Unit&) const {}
    __device__ __forceinline__ void done(const Unit&) const {}
};
template <int MODE> struct SchedX : StaticOrder {
    int off;
    __device__ __forceinline__ bool next(int i, Unit& u) const {
        if (!StaticOrder::next(i, u)) return false;
        if (MODE == 0) u.pm += off;
        if (MODE == 1) u.pn = u.pn < 8 ? u.pn : u.pn + 4;
        if (MODE == 2) u.pn = (u.pm / 12) * 2 + u.pn;
        if (MODE == 3) u.pn = u.pm / 12;
        if (MODE == 4) { if (u.pn >= 2) u.pm += 192; }
        return true;
    }
};

typedef float f32x2 __attribute__((ext_vector_type(2))); typedef __bf16 bf16x2_t __attribute__((ext_vector_type(2))); typedef unsigned u32x2 __attribute__((ext_vector_type(2)));
__device__ __forceinline__ unsigned cvt_pk_bf16(float lo, float hi) { f32x2 v = {lo, hi}; bf16x2_t b = __builtin_convertvector(v, bf16x2_t); return __builtin_bit_cast(unsigned, b); }
__device__ __forceinline__ float sum_xor16(float v) { auto r = __builtin_amdgcn_permlane16_swap(__float_as_uint(v), __float_as_uint(v), false, false); return __uint_as_float(r[0]) + __uint_as_float(r[1]); }
__device__ __forceinline__ float sum_xor32(float v) { auto r = __builtin_amdgcn_permlane32_swap(__float_as_uint(v), __float_as_uint(v), false, false); return __uint_as_float(r[0]) + __uint_as_float(r[1]); }
__device__ __forceinline__ float get_xor16(float v, bool odd_row) { auto r = __builtin_amdgcn_permlane16_swap(__float_as_uint(v), __float_as_uint(v), false, false); return __uint_as_float(odd_row ? r[0] : r[1]); }
__device__ __forceinline__ float bf_lo(unsigned w) { return __uint_as_float(w << 16); }
__device__ __forceinline__ float bf_hi(unsigned w) { return __uint_as_float(w & 0xffff0000u); }
__device__ __forceinline__ u32x4 pack8(f32x4 a, f32x4 b) { u32x4 w; w.x = cvt_pk_bf16(a[0], a[1]); w.y = cvt_pk_bf16(a[2], a[3]); w.z = cvt_pk_bf16(b[0], b[1]); w.w = cvt_pk_bf16(b[2], b[3]); return w; }

__device__ __forceinline__ float rstd_of(unsigned long long ss) { return __builtin_amdgcn_rsqf((float)ss * (1.f / (1048576.f * DM)) + RMS_EPS); }
struct EpiVT { static constexpr bool PERM = true, AFTER_DRAIN = false; static constexpr bool PERM2 = false; static constexpr int NVM = 16;
    bf16_t* O; const unsigned long long* SS;
    __device__ __forceinline__ void operator()(const f32x4 (&acc)[2][2][4][2], const Unit& u, int wr, int wc, int fr, int fq) const {
        asm volatile("" : "+v"(fr), "+v"(fq));
        const int row0 = u.pm * BM + wr * 64 + fr, cl0 = wc * 32 + 8 * fq, col0 = u.pn * BM + cl0;
        f32x4 r0[2], r1[2];
#pragma unroll
        for (int bj = 0; bj < 2; ++bj)
#pragma unroll
            for (int i = 0; i < 4; ++i) { r0[bj][i] = rstd_of(SS[col0 + bj * HALF + i]); r1[bj][i] = rstd_of(SS[col0 + bj * HALF + 4 + i]); }
        bf16_t* tile = O + (size_t)u.pn * (1024 * 256);
#pragma unroll
        for (int ai = 0; ai < 2; ++ai)
#pragma unroll
            for (int m = 0; m < 4; ++m) { bf16_t* rowp = tile + (size_t)(row0 + ai * HALF + m * 16) * 256 + cl0;
#pragma unroll
                for (int bj = 0; bj < 2; ++bj) *(u32x4*)(rowp + bj * HALF) = pack8(acc[ai][bj][m][0] * r0[bj], acc[ai][bj][m][1] * r1[bj]); }
    }
};
struct EpiInProj { static constexpr bool PERM = true, AFTER_DRAIN = false; static constexpr bool PERM2 = false; static constexpr int NVM = 16;
    bf16_t *Q, *K, *US, *UP; const float* rope; const unsigned long long* SS;
    __device__ __forceinline__ void operator()(const f32x4 (&acc)[2][2][4][2], const Unit& u, int wr, int wc, int fr, int fq) const {
        asm volatile("" : "+v"(fr), "+v"(fq));
        const int pn = u.pn, row0 = u.pm * BM + wr * 64 + fr, cw = wc * 32 + 8 * fq;
        if (pn < 8) {
            bf16_t* base = pn < 4 ? Q : K; const int colt = (pn & 3) * BM; const float sc = pn < 4 ? QSCALE : 1.f;
            const bool ropew = (wc & 1) == 0;
#pragma unroll
            for (int ai = 0; ai < 2; ++ai)
#pragma unroll
                for (int m = 0; m < 4; ++m) { const int row = row0 + ai * HALF + m * 16; const int pos = row < NPROMPT ? (row & 2047) : (row & 4095); const float rstd = rstd_of(SS[row]);
                    f32x4 c0 = {1.f, 1.f, 1.f, 1.f}, c1 = c0, s0 = {0.f, 0.f, 0.f, 0.f}, s1 = s0;
                    if (ropew) { c0 = *(const f32x4*)(rope + pos * 8); c1 = *(const f32x4*)(rope + pos * 8 + 4); s0 = *(const f32x4*)(rope + 32768 + pos * 8); s1 = *(const f32x4*)(rope + 32768 + pos * 8 + 4); }
#pragma unroll
                    for (int bj = 0; bj < 2; ++bj) { f32x4 v0 = acc[ai][bj][m][0], v1 = acc[ai][bj][m][1];
                        if (ropew) { f32x4 o0, o1;
#pragma unroll
                            for (int i = 0; i < 4; ++i) { o0[i] = get_xor16(v0[i], (fq & 1) != 0); o1[i] = get_xor16(v1[i], (fq & 1) != 0); }
                            if (fq == 0) { v0 = v0 * c0 - o0 * s0; v1 = v1 * c1 - o1 * s1; } else if (fq == 1) { v0 = v0 * c0 + o0 * s0; v1 = v1 * c1 + o1 * s1; } }
                        v0 = v0 * (sc * rstd); v1 = v1 * (sc * rstd);
                        *(u32x4*)(base + (size_t)row * 1024 + colt + bj * HALF + cw) = pack8(v0, v1); }
                    asm volatile("" ::: "memory"); }
        } else if (pn < 14) {
#pragma unroll
            for (int ai = 0; ai < 2; ++ai)
#pragma unroll
                for (int m = 0; m < 4; ++m) { const int row = row0 + ai * HALF + m * 16; const float rstd = rstd_of(SS[row]);
#pragma unroll
                    for (int bj = 0; bj < 2; ++bj) { const int cc = (pn - 12) * BM + bj * HALF + cw, g = cc >> 4, h0 = cc & 15;
                        *(u32x4*)(US + ((size_t)g * NTOK + row) * 16 + h0) = pack8(acc[ai][bj][m][0] * rstd, acc[ai][bj][m][1] * rstd); } }
        } else {
#pragma unroll
            for (int ai = 0; ai < 2; ++ai)
#pragma unroll
                for (int m = 0; m < 4; ++m) { const int row = row0 + ai * HALF + m * 16; const float rstd = rstd_of(SS[row]);
#pragma unroll
                    for (int bj = 0; bj < 2; ++bj) { const int cc = (pn - 14) * BM + bj * HALF + cw;
                        *(u32x4*)(UP + (size_t)row * 512 + cc) = pack8(acc[ai][bj][m][0] * rstd, acc[ai][bj][m][1] * rstd); } }
        }
    }
};
struct EpiSsm1 { static constexpr bool PERM = true, AFTER_DRAIN = false; static constexpr bool PERM2 = false; static constexpr int NVM = 16;
    bf16_t* YI; size_t zoff;
    __device__ __forceinline__ void operator()(const f32x4 (&acc)[2][2][4][2], const Unit& u, int wr, int wc, int fr, int fq) const {
        asm volatile("" : "+v"(fr), "+v"(fq));
        const int row0 = u.pm * BM + wr * 64 + fr, col0 = wc * 32 + 8 * fq; bf16_t* O = YI + (size_t)(u.pn & 1) * zoff;
#pragma unroll
        for (int ai = 0; ai < 2; ++ai)
#pragma unroll
            for (int m = 0; m < 4; ++m) { bf16_t* rp = O + (size_t)(row0 + ai * HALF + m * 16) * 256 + col0;
#pragma unroll
                for (int bj = 0; bj < 2; ++bj) *(u32x4*)(rp + bj * HALF) = pack8(acc[ai][bj][m][0], acc[ai][bj][m][1]); }
    }
};
__device__ __forceinline__ float gelu_tanh(float y) {
    const float u2 = 1.5957691216057308f * (y + 0.044715f * y * y * y);
    return y * __builtin_amdgcn_rcpf(1.f + __builtin_amdgcn_exp2f(-1.4426950408889634f * u2));
}
struct EpiSsm2 { static constexpr bool PERM = true, AFTER_DRAIN = false; static constexpr bool PERM2 = false; static constexpr int NVM = 32;
    const bf16_t* YI; bf16_t* ZB;
    __device__ __forceinline__ void operator()(const f32x4 (&acc)[2][2][4][2], const Unit& u, int wr, int wc, int fr, int fq) const {
        asm volatile("" : "+v"(fr), "+v"(fq));
        const int g = u.pn, row0 = u.pm * BM + wr * 64 + fr, col0 = wc * 32 + 8 * fq;
#pragma unroll
        for (int ai = 0; ai < 2; ++ai)
#pragma unroll
            for (int m = 0; m < 4; ++m) { const int row = row0 + ai * HALF + m * 16, chunk = row - g * NCHUNK;
#pragma unroll
                for (int bj = 0; bj < 2; ++bj) { const int col = col0 + bj * HALF; const u32x4 yi = *(const u32x4*)(YI + (size_t)row * 256 + col); const f32x4 a = acc[ai][bj][m][0], b = acc[ai][bj][m][1];
                    const f32x4 v = {gelu_tanh(a[0] + bf_lo(yi.x)), gelu_tanh(a[1] + bf_hi(yi.x)), gelu_tanh(a[2] + bf_lo(yi.y)), gelu_tanh(a[3] + bf_hi(yi.y))};
                    const f32x4 w = {gelu_tanh(b[0] + bf_lo(yi.z)), gelu_tanh(b[1] + bf_hi(yi.z)), gelu_tanh(b[2] + bf_lo(yi.w)), gelu_tanh(b[3] + bf_hi(yi.w))};
                    *(u32x4*)(ZB + (size_t)(chunk * CH_T + (col >> 4)) * 512 + g * 16 + (col & 15)) = pack8(v, w); }
                asm volatile("" ::: "memory"); }
    }
};
struct EpiGluPool { static constexpr bool PERM = true, AFTER_DRAIN = false; static constexpr bool PERM2 = false; static constexpr int NVM = 16;
    const bf16_t* ZB; const float* glu_b; bf16_t* MIX;
    __device__ __forceinline__ void operator()(const f32x4 (&acc)[2][2][4][2], const Unit& u, int wr, int wc, int fr, int fq) const {
        asm volatile("" : "+v"(fr), "+v"(fq));
        const bool glu = u.pn < 2; const int pm = glu ? u.pm : u.pm - 192, pn = glu ? u.pn : u.pn - 2;
        const int row0 = pm * BM + wr * 64 + fr, col0 = pn * BM + wc * 32 + 8 * fq;
#pragma unroll
        for (int ai = 0; ai < 2; ++ai)
#pragma unroll
            for (int m = 0; m < 4; ++m) { const int row = row0 + ai * HALF + m * 16;
#pragma unroll
                for (int bj = 0; bj < 2; ++bj) { const int col = col0 + bj * HALF; f32x4 v0 = acc[ai][bj][m][0], v1 = acc[ai][bj][m][1];
                    if (glu) { const u32x4 zz = *(const u32x4*)(ZB + (size_t)row * 512 + col); const f32x4 b0 = *(const f32x4*)(glu_b + col), b1 = *(const f32x4*)(glu_b + col + 4);
                        const float z[8] = {bf_lo(zz.x), bf_hi(zz.x), bf_lo(zz.y), bf_hi(zz.y), bf_lo(zz.z), bf_hi(zz.z), bf_lo(zz.w), bf_hi(zz.w)};
#pragma unroll
                        for (int i = 0; i < 4; ++i) { v0[i] = z[i] * __builtin_amdgcn_rcpf(1.f + __builtin_amdgcn_exp2f(-1.4426950408889634f * (v0[i] + b0[i])));
                                                      v1[i] = z[4 + i] * __builtin_amdgcn_rcpf(1.f + __builtin_amdgcn_exp2f(-1.4426950408889634f * (v1[i] + b1[i]))); } }
                    *(u32x4*)(MIX + (size_t)row * DM + (glu ? 1024 : 1536) + col) = pack8(v0, v1); } }
    }
};
struct EpiResidX { static constexpr bool PERM = true, AFTER_DRAIN = false; static constexpr bool PERM2 = false; static constexpr int NVM = 32;
    const bf16_t* XI; bf16_t* XO; unsigned long long* SS; int row_off;
    __device__ __forceinline__ void operator()(const f32x4 (&acc)[2][2][4][2], const Unit& u, int wr, int wc, int fr, int fq) const {
        asm volatile("" : "+v"(fr), "+v"(fq));
        const int row0 = u.pm * BM + wr * 64 + fr + row_off, col0 = u.pn * BM + wc * 32 + 8 * fq;
#pragma unroll
        for (int ai = 0; ai < 2; ++ai) {
            u32x4 bv[4][2];
#pragma unroll
            for (int m = 0; m < 4; ++m) { const bf16_t* bp = XI + (size_t)(row0 + ai * HALF + m * 16) * DM + col0;
#pragma unroll
                for (int bj = 0; bj < 2; ++bj) bv[m][bj] = *(const u32x4*)(bp + bj * HALF); }
#pragma unroll
            for (int m = 0; m < 4; ++m) { const int row = row0 + ai * HALF + m * 16; bf16_t* xp = XO + (size_t)row * DM + col0;
                float s = 0.f;
#pragma unroll
                for (int bj = 0; bj < 2; ++bj) { const u32x4 x = bv[m][bj]; const f32x4 a = acc[ai][bj][m][0], b = acc[ai][bj][m][1];
                    const f32x4 v = {bf_lo(x.x) + a[0], bf_hi(x.x) + a[1], bf_lo(x.y) + a[2], bf_hi(x.y) + a[3]}, w = {bf_lo(x.z) + b[0], bf_hi(x.z) + b[1], bf_lo(x.w) + b[2], bf_hi(x.w) + b[3]};
                    s += ((v[0] * v[0] + v[1] * v[1]) + (v[2] * v[2] + v[3] * v[3])) + ((w[0] * w[0] + w[1] * w[1]) + (w[2] * w[2] + w[3] * w[3]));
                    *(u32x4*)(xp + bj * HALF) = pack8(v, w); }
                s = sum_xor32(sum_xor16(s));
                if (fq == 0) __hip_atomic_fetch_add(SS + row, (unsigned long long)(s * 1048576.f + 0.5f), __ATOMIC_RELAXED, __HIP_MEMORY_SCOPE_AGENT); }
            asm volatile("" ::: "memory");
        }
    }
};
struct EpiSqRelu { static constexpr bool PERM = true, AFTER_DRAIN = false; static constexpr bool PERM2 = true; static constexpr int NVM = 16;
    bf16_t* HID; int row_off; const unsigned long long* SS;
    __device__ __forceinline__ void operator()(const f32x4 (&acc)[2][2][4][2], const Unit& u, int wr, int wc, int fr, int fq) const {
        asm volatile("" : "+v"(fr), "+v"(fq));
        const int rown = u.pm * BM + wr * 64 + fr;
        bf16_t* base = HID + (size_t)(u.pm * BM + wr * 64 + (fr & 7) - row_off) * DFF + u.pn * BM + wc * 64 + 32 * (fr >> 3) + 8 * fq;
#pragma unroll
        for (int ai = 0; ai < 2; ++ai)
#pragma unroll
            for (int m = 0; m < 4; ++m) { const float rstd = rstd_of(SS[rown + ai * HALF + m * 16]);
                u32x4 d[2];
#pragma unroll
                for (int bj = 0; bj < 2; ++bj) { f32x4 v0 = acc[ai][bj][m][0], v1 = acc[ai][bj][m][1];
#pragma unroll
                    for (int i = 0; i < 4; ++i) { const float a = fmaxf(v0[i], 0.f) * rstd, b = fmaxf(v1[i], 0.f) * rstd; v0[i] = a * a; v1[i] = b * b; }
                    d[bj] = pack8(v0, v1); }
                u32x4 x, y;
#pragma unroll
                for (int i = 0; i < 4; ++i) { x[i] = (unsigned)__builtin_amdgcn_update_dpp((int)d[0][i], (int)d[1][i], 0x128, 0xF, 0xC, false);
                                              y[i] = (unsigned)__builtin_amdgcn_update_dpp((int)d[1][i], (int)d[0][i], 0x128, 0xF, 0x3, false); }
                bf16_t* p = base + (size_t)(ai * HALF + m * 16) * DFF;
                *(u32x4*)p = x; *(u32x4*)(p + (size_t)8 * DFF) = y; }
    }
};

#ifdef PROBE_EPI2
template <class E> struct Probe2 { static constexpr bool v = false; };
#if PROBE_EPI2 == 1
template <> struct Probe2<EpiInProj> { static constexpr bool v = true; };
template <> struct Probe2<EpiVT> { static constexpr bool v = true; };
#else
template <> struct Probe2<EpiSqRelu> { static constexpr bool v = true; };
#endif
#endif
template <class Epi, class Sched, bool ALIGN_EPI = false, bool SP2 = false>
__device__ __forceinline__ void gemm_phase(PG8_LAS unsigned char* lds, const Gemm g, const Sched& S, const Epi& E, int tid_) {
    asm volatile("" : "+v"(tid_));
    const int tid = tid_, wid = __builtin_amdgcn_readfirstlane(tid >> 6), lane = tid & 63, wr = wid >> 2, wc = wid & 3, fr = lane & 15, fq = lane >> 4;
    const int K = g.K, nt = K / BK;
    unsigned voffA[2], voffB[2];
#pragma unroll
    for (int i = 0; i < 2; ++i) { int R, C; stage_rc(tid * 16 + i * 8192, R, C); const int Rb = Epi::PERM2 ? ((R >> 5) * 64 + perm32(R & 31)) : Epi::PERM ? ((R & ~31) + perm32(R & 31)) : R;
        voffA[i] = (unsigned)(R * K + C) * 2u; voffB[i] = (unsigned)(Rb * K + C) * 2u; }
    const size_t kstep = (size_t)(BK * 2);
    const size_t hstep = (size_t)HALF * K * 2;
    const size_t hstepB = Epi::PERM2 ? (size_t)32 * K * 2 : hstep;
    const size_t tstep = 2 * hstep;
    const unsigned ldsw = (unsigned)wid * 1024u;
    const int aoff = lds_byte(wr * 64 + fr, fq * 8), boff = lds_byte(wc * 32 + fr, fq * 8);
#define PG8_SA(b, h) (((b) * 2 + (h)) * HTB)
#define PG8_SB(b, h) ((4 + (b) * 2 + (h)) * HTB)
    const unsigned lds_u32 = (unsigned)(uintptr_t)lds + ldsw;
#define PG8_STAGE(bufoff, gbase, voff) do { _Pragma("unroll") for (int _i = 0; _i < 2; ++_i) \
        glds_saddr((const char*)(gbase), (voff)[_i], lds_u32 + (unsigned)((bufoff) + _i * 8192)); } while (0)
#define PG8_LDA(dst, b, h) do { _Pragma("unroll") for (int m = 0; m < 4; ++m) _Pragma("unroll") for (int k = 0; k < 2; ++k) dst[m][k] = *(const PG8_LAS bf16x8*)(lds + PG8_SA(b, h) + aoff + m * 2048 + k * 1024); } while (0)
#define PG8_LDB(dst, b, h) do { _Pragma("unroll") for (int n = 0; n < 2; ++n) _Pragma("unroll") for (int k = 0; k < 2; ++k) dst[n][k] = *(const PG8_LAS bf16x8*)(lds + PG8_SB(b, h) + boff + n * 2048 + k * 1024); } while (0)
#define PG8_MMA(ai, bj, At, Bt) do { __builtin_amdgcn_s_setprio(1); _Pragma("unroll") for (int m = 0; m < 4; ++m) _Pragma("unroll") for (int n = 0; n < 2; ++n) _Pragma("unroll") for (int k = 0; k < 2; ++k) \
        acc[ai][bj][m][n] = __builtin_amdgcn_mfma_f32_16x16x32_bf16(Bt[n][k], At[m][k], acc[ai][bj][m][n], 0, 0, 0); __builtin_amdgcn_s_setprio(0); } while (0)
#define PG8_WAIT_V(n) asm volatile("s_waitcnt vmcnt(" #n ")" ::: "memory")
#define PG8_WAIT_L(n) asm volatile("s_waitcnt lgkmcnt(" #n ")" ::: "memory")
#define PG8_WAIT_VR(rx) do { if (rx) asm volatile("s_waitcnt vmcnt(%0)" :: "n"(8 + Epi::NVM) : "memory"); else PG8_WAIT_V(8); } while (0)
#define PG8_BAR __builtin_amdgcn_s_barrier()
#define PG8_SCHED __builtin_amdgcn_sched_barrier(0)
    Unit cur, nxt; int ui = 0;
    if (!S.next(0, cur)) return;
    f32x4 acc[2][2][4][2];
#pragma unroll
    for (int a = 0; a < 2; ++a)
#pragma unroll
        for (int b = 0; b < 2; ++b)
#pragma unroll
            for (int m = 0; m < 4; ++m)
#pragma unroll
                for (int n = 0; n < 2; ++n) acc[a][b][m][n] = (f32x4){0.f, 0.f, 0.f, 0.f};
    bf16x8 At[4][2], B0[2][2], B1[2][2];
    const char* cA = (const char*)g.A + (size_t)cur.pm * tstep; const char* cB = (const char*)g.Bt + (size_t)cur.pn * tstep;
    S.a_ready(cur);
    if constexpr (SP2) {
        PG8_STAGE(PG8_SB(0, 0), cB, voffB); PG8_STAGE(PG8_SB(0, 1), cB + hstepB, voffB); PG8_STAGE(PG8_SA(0, 0), cA, voffA); PG8_STAGE(PG8_SA(0, 1), cA + hstep, voffA);
        if (wr == 1) PG8_BAR;
        PG8_WAIT_V(2); PG8_BAR;
        PG8_STAGE(PG8_SB(1, 0), cB + kstep, voffB); PG8_STAGE(PG8_SA(1, 0), cA + kstep, voffA); PG8_STAGE(PG8_SB(1, 1), cB + hstepB + kstep, voffB);
        PG8_WAIT_V(0); PG8_BAR;
    } else {
        PG8_STAGE(PG8_SB(0, 0), cB, voffB); PG8_STAGE(PG8_SA(0, 0), cA, voffA); PG8_STAGE(PG8_SB(0, 1), cB + hstepB, voffB); PG8_STAGE(PG8_SA(0, 1), cA + hstep, voffA);
        if (wr == 1) PG8_BAR;
        PG8_WAIT_V(4); PG8_BAR;
        PG8_STAGE(PG8_SB(1, 0), cB + kstep, voffB); PG8_STAGE(PG8_SA(1, 0), cA + kstep, voffA); PG8_STAGE(PG8_SB(1, 1), cB + hstepB + kstep, voffB);
        PG8_WAIT_V(6); PG8_BAR;
    }
    for (;;) {
        const bool has_next = S.next(ui + 1, nxt);
        const char* nA = has_next ? (const char*)g.A + (size_t)nxt.pm * tstep : cA; const char* nB = has_next ? (const char*)g.Bt + (size_t)nxt.pn * tstep : cB;
        for (int t = 0; t < nt; t += 2) {
            const bool last = (t == nt - 2);
            const bool relax = SP2 && (t == 0);
            const char* a1 = cA + (size_t)(t + 1) * kstep;
            const char* a2 = last ? nA : cA + (size_t)(t + 2) * kstep; const char* b2 = last ? nB : cB + (size_t)(t + 2) * kstep;
            const char* a3 = a2 + kstep; const char* b3 = b2 + kstep;
            if (last && has_next) S.a_ready(nxt);
            if constexpr (SP2) {
            PG8_LDB(B0, 0, 0); PG8_LDB(B1, 0, 1); PG8_SCHED; PG8_LDA(At, 0, 0); PG8_STAGE(PG8_SA(1, 1), a1 + hstep, voffA);
            PG8_WAIT_VR(relax); PG8_WAIT_L(0); PG8_BAR; PG8_MMA(0, 0, At, B0); PG8_MMA(0, 1, At, B1); PG8_BAR; PG8_SCHED;
            PG8_LDA(At, 0, 1); PG8_STAGE(PG8_SB(0, 0), b2, voffB); PG8_STAGE(PG8_SB(0, 1), b2 + hstepB, voffB); PG8_STAGE(PG8_SA(0, 0), a2, voffA);
            PG8_WAIT_VR(relax); PG8_WAIT_L(0); PG8_BAR; PG8_MMA(1, 0, At, B0); PG8_MMA(1, 1, At, B1); PG8_BAR; PG8_SCHED;
            PG8_LDB(B0, 1, 0); PG8_LDB(B1, 1, 1); PG8_SCHED; PG8_LDA(At, 1, 0); PG8_STAGE(PG8_SA(0, 1), a2 + hstep, voffA);
            PG8_WAIT_V(8); PG8_WAIT_L(0); PG8_BAR; PG8_MMA(0, 0, At, B0); PG8_MMA(0, 1, At, B1); PG8_BAR; PG8_SCHED;
            PG8_LDA(At, 1, 1); PG8_STAGE(PG8_SB(1, 0), b3, voffB); PG8_STAGE(PG8_SB(1, 1), b3 + hstepB, voffB); PG8_STAGE(PG8_SA(1, 0), a3, voffA);
            PG8_WAIT_V(8); PG8_WAIT_L(0); PG8_BAR; PG8_MMA(1, 0, At, B0); PG8_MMA(1, 1, At, B1); PG8_BAR; PG8_SCHED;
            } else {
            PG8_LDB(B0, 0, 0); PG8_SCHED; PG8_LDA(At, 0, 0); PG8_STAGE(PG8_SA(1, 1), a1 + hstep, voffA);
            PG8_WAIT_L(8); PG8_BAR; PG8_WAIT_L(0); PG8_MMA(0, 0, At, B0); PG8_BAR; PG8_SCHED;
            PG8_LDB(B1, 0, 1); PG8_STAGE(PG8_SB(0, 0), b2, voffB);
            PG8_BAR; PG8_WAIT_L(0); PG8_MMA(0, 1, At, B1); PG8_BAR;
            PG8_LDA(At, 0, 1); PG8_STAGE(PG8_SA(0, 0), a2, voffA);
            PG8_BAR; PG8_WAIT_L(0); PG8_MMA(1, 0, At, B0); PG8_BAR; PG8_SCHED;
            PG8_STAGE(PG8_SB(0, 1), b2 + hstepB, voffB);
            PG8_WAIT_V(6); PG8_BAR; PG8_MMA(1, 1, At, B1); PG8_BAR;
            PG8_LDB(B0, 1, 0); PG8_SCHED; PG8_LDA(At, 1, 0); PG8_STAGE(PG8_SA(0, 1), a2 + hstep, voffA);
            PG8_WAIT_L(8); PG8_BAR; PG8_WAIT_L(0); PG8_MMA(0, 0, At, B0); PG8_BAR; PG8_SCHED;
            PG8_LDB(B1, 1, 1); PG8_STAGE(PG8_SB(1, 0), b3, voffB);
            PG8_BAR; PG8_WAIT_L(0); PG8_MMA(0, 1, At, B1); PG8_BAR;
            PG8_LDA(At, 1, 1); PG8_STAGE(PG8_SA(1, 0), a3, voffA);
            PG8_BAR; PG8_WAIT_L(0); PG8_MMA(1, 0, At, B0); PG8_BAR; PG8_SCHED;
            PG8_STAGE(PG8_SB(1, 1), b3 + hstepB, voffB);
            PG8_WAIT_V(6); PG8_BAR; PG8_MMA(1, 1, At, B1); PG8_BAR;
            }
        }
        if constexpr (ALIGN_EPI) { if (wr == 0) PG8_BAR; }
        if constexpr (!Epi::AFTER_DRAIN) { E(acc, cur, wr, wc, fr, fq);
#ifdef PROBE_EPI2
            if constexpr (Probe2<Epi>::v) { asm volatile("" ::: "memory"); E(acc, cur, wr, wc, fr, fq); }
#endif
            S.done(cur); }
        if (!has_next) break;
#pragma unroll
        for (int a = 0; a < 2; ++a)
#pragma unroll
            for (int b = 0; b < 2; ++b)
#pragma unroll
                for (int m = 0; m < 4; ++m)
#pragma unroll
                    for (int n = 0; n < 2; ++n) acc[a][b][m][n] = (f32x4){0.f, 0.f, 0.f, 0.f};
        cur = nxt; cA = nA; cB = nB; ++ui;
        if constexpr (ALIGN_EPI) { if (wr == 1) PG8_BAR; }
    }
    PG8_WAIT_V(0);
    if constexpr (!ALIGN_EPI) { if (wr == 0) PG8_BAR; }
    PG8_BAR;
    if constexpr (Epi::AFTER_DRAIN) { E.fused(acc, cur, wr, wc, fr, fq, lds, wid, lane); S.done(cur); }
#undef PG8_SA
#undef PG8_SB
#undef PG8_STAGE
#undef PG8_LDA
#undef PG8_LDB
#undef PG8_MMA
#undef PG8_WAIT_V
#undef PG8_WAIT_L
#undef PG8_WAIT_VR
#undef PG8_BAR
#undef PG8_SCHED
}
}
constexpr int NWAVES = 8;
constexpr size_t MiB = 1u << 20;
constexpr size_t WS_CTL = 0, CTL_ZERO_BYTES = 1 * MiB;
constexpr size_t WS_SS = 4 * MiB, SS_BYTES = 4 * MiB;
constexpr size_t WS_ROPE = 1 * MiB;
constexpr size_t WS_AT = 2 * MiB;
constexpr size_t WS_WIN = 16 * MiB, WS_WOUT = 32 * MiB, WS_WUP = 40 * MiB, WS_WDN = 72 * MiB;
constexpr size_t WS_SSM1 = 104 * MiB, WS_SSM2 = 112 * MiB, WS_GP = 116 * MiB;
constexpr size_t WS_HB = 120 * MiB;
constexpr size_t WS_Q = 312 * MiB, WS_K = 408 * MiB, WS_VT = 504 * MiB, WS_US = 600 * MiB, WS_UP = 648 * MiB;
constexpr size_t WS_YI = 696 * MiB, WS_Z = 744 * MiB, WS_SP = 840 * MiB, WS_ZB = 888 * MiB, WS_PL = 936 * MiB;
constexpr size_t WS_HID = 312 * MiB;
constexpr size_t WS_END = 984 * MiB;
static_assert(WS_PL == WS_ZB + (size_t)NTOK * 512 * 2 && WS_HID + (size_t)8192 * DFF * 2 <= WS_YI, "ws map");
constexpr int CW_BAR = 4096;
constexpr int RING_BYTES = 131072, LDSCTL_OFF = RING_BYTES, MISC_OFF = LDSCTL_OFF + 320, LDS_BYTES = 147456;

#define GAS __attribute__((address_space(1)))
#define LAS __attribute__((address_space(3)))
typedef unsigned short bf16;
typedef unsigned v4u __attribute__((ext_vector_type(4)));
typedef unsigned v2u __attribute__((ext_vector_type(2)));
typedef float f32x4 __attribute__((ext_vector_type(4)));
typedef float f32x16 __attribute__((ext_vector_type(16)));
typedef short bf16x8 __attribute__((ext_vector_type(8)));
typedef GAS unsigned gu32;
#define LDS_WAIT() asm volatile("s_waitcnt lgkmcnt(0)" ::: "memory")
#define VM_WAIT() asm volatile("s_waitcnt vmcnt(0)" ::: "memory")
using pg8::cvt_pk_bf16; using pg8::bf_lo; using pg8::bf_hi;

#define XB_TMO      128
#define XB_XCNT(j)  (256  + 64 * (j))
#define XB_XSUB(j)  (1280 + 64 * (j))
#define XB_XGEN(j)  (2304 + 64 * (j))
#define XB_TOP      3328
#define XB_TOPGEN   3392
#define XCD_BAR_WORDS 3456
#define XB_SPIN_CAP (1u << 18)

__device__ __forceinline__ unsigned xb_ld(unsigned* p)              { return __hip_atomic_load(p, __ATOMIC_RELAXED, __HIP_MEMORY_SCOPE_AGENT); }
__device__ __forceinline__ unsigned xb_add(unsigned* p, unsigned v) { return __hip_atomic_fetch_add(p, v, __ATOMIC_RELAXED, __HIP_MEMORY_SCOPE_AGENT); }
__device__ __forceinline__ unsigned xb_xcc_id() { return (unsigned)__builtin_amdgcn_s_getreg((3 << 11) | 20) & 0xFu; }
#define XB_SPIN(cond, bar) do { unsigned _sp = 0; while (cond) { __builtin_amdgcn_s_sleep(1); \
    if ((++_sp & 255u) == 0u) { if (xb_ld(&(bar)[XB_TMO])) break; if (_sp > XB_SPIN_CAP) { atomicAdd(&(bar)[XB_TMO], 1u); break; } } } } while (0)

struct XcdBarrier {
    unsigned* bar; unsigned x;
    volatile LAS unsigned* st;
};

__device__ __forceinline__ XcdBarrier xcd_barrier_post(unsigned* bar, volatile LAS unsigned* st) {
    XcdBarrier b; b.bar = bar; b.x = xb_xcc_id(); b.st = st;
    if (threadIdx.x == 0) (void)xb_add(&bar[XB_XCNT(b.x)], 1u);
    return b;
}
__device__ __forceinline__ void xcd_barrier_complete(unsigned* bar, unsigned x, unsigned& nloc, unsigned& nx) {
    const unsigned G = gridDim.x * gridDim.y * gridDim.z;
    unsigned sum, cnt, mine, sp = 0u;
    for (;;) {
        sum = 0u; cnt = 0u; mine = 0u;
#pragma unroll
        for (unsigned j = 0; j < 16; ++j) { const unsigned c = xb_ld(&bar[XB_XCNT(j)]); sum += c; cnt += (c > 0u) ? 1u : 0u; mine = (j == x) ? c : mine; }
        if (sum == G) break;
        __builtin_amdgcn_s_sleep(1);
        if ((++sp & 255u) == 0u) { if (xb_ld(&bar[XB_TMO])) break; if (sp > XB_SPIN_CAP) { atomicAdd(&bar[XB_TMO], 1u); break; } }
    }
    nloc = mine > 0u ? mine : 1u; nx = cnt > 0u ? cnt : 1u;
}

__device__ __forceinline__ void xcd_barrier(const XcdBarrier& b) {
    asm volatile("s_waitcnt vmcnt(0)" ::: "memory");
    __syncthreads();
    if (threadIdx.x == 0) {
        unsigned* bar = b.bar;
        __builtin_amdgcn_s_waitcnt(0);
        unsigned nloc = b.st[0], nx = b.st[1];
        if (nloc == 0u) { xcd_barrier_complete(bar, b.x, nloc, nx); b.st[0] = nloc; b.st[1] = nx; }
        const unsigned old = xb_add(&bar[XB_XSUB(b.x)], 1u);
        const unsigned gen = old / nloc;
        if (old + 1u == (gen + 1u) * nloc) {
            __builtin_amdgcn_fence(__ATOMIC_RELEASE, "agent");
            asm volatile("s_waitcnt vmcnt(0)" ::: "memory");
            const unsigned og = xb_add(&bar[XB_TOP], 1u);
            const unsigned tg = og / nx;
            if (og + 1u == (tg + 1u) * nx) xb_add(&bar[XB_TOPGEN], 1u);
            else XB_SPIN(xb_ld(&bar[XB_TOPGEN]) == tg, bar);
            __builtin_amdgcn_fence(__ATOMIC_ACQUIRE, "agent");
            xb_add(&bar[XB_XGEN(b.x)], 1u);
            asm volatile("s_waitcnt vmcnt(0)" ::: "memory");
        } else {
            XB_SPIN(xb_ld(&bar[XB_XGEN(b.x)]) == gen, bar);
            __builtin_amdgcn_fence(__ATOMIC_ACQUIRE, "agent");
            asm volatile("s_waitcnt vmcnt(0)" ::: "memory");
        }
    }
    __syncthreads();
}
struct Frame {
    LAS unsigned char* lds;
    int tid, lane, wave, vcu, G;
    float* out; unsigned char* ws;
};
__device__ __forceinline__ float wave_sum(float v, int lane) {
#pragma unroll
    for (int o = 1; o < 16; o <<= 1) v += __uint_as_float((unsigned)__builtin_amdgcn_ds_bpermute((lane ^ o) << 2, (int)__float_as_uint(v)));
    return pg8::sum_xor32(pg8::sum_xor16(v));
}
__device__ __forceinline__ void transpose_item(const float* W, int K, int N, bf16* WT, LAS float* scr, int item, int lane, const float* gain = nullptr) {
    const int nblk = N / 32, kb = item / nblk, nb = item % nblk, k0 = 64 * kb, n0 = 32 * nb;
#pragma unroll 8
    for (int i = 0; i < 32; ++i) { const int kk = 2 * i + (lane >> 5); scr[kk * 33 + (lane & 31)] = W[(size_t)(k0 + kk) * N + n0 + (lane & 31)] * (gain ? gain[k0 + kk] : 1.f); }
    LDS_WAIT(); asm volatile("" ::: "memory");
    const int c = lane & 7;
#pragma unroll
    for (int j = 0; j < 4; ++j) { const int n = (lane >> 3) + 8 * j; const LAS float* s = scr + (8 * c) * 33 + n;
        v4u o; o.x = cvt_pk_bf16(s[0 * 33], s[1 * 33]); o.y = cvt_pk_bf16(s[2 * 33], s[3 * 33]); o.z = cvt_pk_bf16(s[4 * 33], s[5 * 33]); o.w = cvt_pk_bf16(s[6 * 33], s[7 * 33]);
        *(v4u*)(WT + (size_t)(n0 + n) * K + k0 + 8 * c) = o; }
    LDS_WAIT(); asm volatile("" ::: "memory");
}
struct WPtrs { const float *w_in, *w_out, *glu_w, *pool_w, *pool_s, *w_up, *w_dn, *g_mix, *g_mlp; };
__device__ __forceinline__ void convert_weights(Frame& F, const WPtrs& W, int l, int what, int cu_idx, int cu_cnt) {
    LAS float* scr = (LAS float*)(F.lds + F.wave * 16384);
    const int gw = cu_idx * NWAVES + F.wave, NGW = cu_cnt * NWAVES;
    bf16* Win_t = (bf16*)(F.ws + WS_WIN); bf16* Wout_t = (bf16*)(F.ws + WS_WOUT); bf16* Wup_t = (bf16*)(F.ws + WS_WUP); bf16* Wdn_t = (bf16*)(F.ws + WS_WDN); bf16* GP = (bf16*)(F.ws + WS_GP);
    if (what & 1) {
        const float* w_in = W.w_in + (size_t)l * DM * 4096; const float* w_out = W.w_out + (size_t)l * DM * DM; const float* glu_w = W.glu_w + (size_t)l * 512 * 512;
        constexpr int I_IN = (DM / 64) * (4096 / 32), I_OUT = (DM / 64) * (DM / 32), I_GLU = (512 / 64) * (512 / 32);
        for (int it = gw; it < I_IN + I_OUT + I_GLU; it += NGW) {
            int r = it;
            if (r < I_IN) { transpose_item(w_in, DM, 4096, Win_t, scr, r, F.lane, W.g_mix + (size_t)l * DM); continue; } r -= I_IN;
            if (r < I_OUT) { transpose_item(w_out, DM, DM, Wout_t, scr, r, F.lane); continue; } r -= I_OUT;
            transpose_item(glu_w, 512, 512, GP, scr, r, F.lane);
        }
        const float* pool_w = W.pool_w + (size_t)l * 4 * 128 * 128; const float* pool_s = W.pool_s + (size_t)l * 512;
        for (int e = (cu_idx * 512 + F.tid); e < 512 * 512; e += cu_cnt * 512) { const int n = e >> 9, k = e & 511, gi = n >> 7, gj = k >> 7;
            const float v = (gi == gj) ? pool_w[((size_t)gi * 128 + (k & 127)) * 128 + (n & 127)] * pool_s[n] : 0.f;
            GP[(size_t)(512 + n) * 512 + k] = (bf16)(cvt_pk_bf16(v, 0.f) & 0xffffu); }
    }
    if (what & 2) {
        const float* w_up = W.w_up + (size_t)l * DM * DFF; const float* w_dn = W.w_dn + (size_t)l * DFF * DM;
        constexpr int I_UP = (DM / 64) * (DFF / 32), I_DN = (DFF / 64) * (DM / 32);
        for (int it = gw; it < I_UP + I_DN; it += NGW) {
            if (it < I_UP) transpose_item(w_up, DM, DFF, Wup_t, scr, it, F.lane, W.g_mlp + (size_t)l * DM); else transpose_item(w_dn, DFF, DM, Wdn_t, scr, it - I_UP, F.lane);
        }
    }
    if (what & 4) {
        float* rope = (float*)(F.ws + WS_ROPE);
        for (int e = cu_idx * 512 + F.tid; e < 4096 * 8; e += cu_cnt * 512) { const int pos = e >> 3, j = e & 7;
            const float inv = powf(500000.0f, -(float)(2 * j) / 16.0f); const float ang = (float)pos * inv; float s, c; sincosf(ang, &s, &c);
            rope[e] = c; rope[32768 + e] = s; }
    }
}
struct SPtrs { const float *lam_re, *lam_im, *log_dt, *b_re, *b_im, *c_re, *c_im, *d; };
__device__ __forceinline__ void ssm_weights(Frame& F, const SPtrs& S, int l) {
    typedef float f2 __attribute__((ext_vector_type(2)));
    LAS f2* AP = (LAS f2*)F.lds;
    LAS f2* BB = AP + 2 * 64 * 17;
    LAS f2* CC = BB + 2 * 64 * 16;
    LAS float* KT = (LAS float*)(CC + 2 * 16 * 64);
    const float* lam_re = S.lam_re; const float* lam_im = S.lam_im; const float* log_dt = S.log_dt;
    const float* b_re = S.b_re; const float* b_im = S.b_im; const float* c_re = S.c_re; const float* c_im = S.c_im; const float* dskip = S.d + (size_t)l * 512;
    bf16* W1 = (bf16*)(F.ws + WS_SSM1); bf16* W2 = (bf16*)(F.ws + WS_SSM2); float* AT = (float*)(F.ws + WS_AT);
    for (int g = blockIdx.x; g < NGRP; g += F.G) {
        __syncthreads();
        if (F.tid < 128) { const int dir = F.tid >> 6, p = F.tid & 63; const int idx = (l * 2 + dir) * NGRP + g;
            const float lr = lam_re[(size_t)idx * 64 + p], li = lam_im[(size_t)idx * 64 + p], dt = expf(log_dt[idx]);
            for (int k = 0; k <= 16; ++k) { const float mag = expf(lr * dt * (float)k); float s, c; sincosf(li * dt * (float)k, &s, &c); AP[(dir * 64 + p) * 17 + k] = (f2){mag * c, mag * s}; }
            float s1, c1; sincosf(li * dt, &s1, &c1); const float mag1 = expf(lr * dt), ai = mag1 * s1; const float sh = sinf(0.5f * li * dt);
            const float nr = expm1f(lr * dt) * c1 - 2.f * sh * sh;
            const float den = lr * lr + li * li, cr = (nr * lr + ai * li) / den, ci = (ai * lr - nr * li) / den;
            for (int h = 0; h < 16; ++h) { const float br = b_re[((size_t)idx * 64 + p) * 16 + h], bi = b_im[((size_t)idx * 64 + p) * 16 + h]; BB[(dir * 64 + p) * 16 + h] = (f2){cr * br - ci * bi, cr * bi + ci * br}; }
            const f2 a16 = AP[(dir * 64 + p) * 17 + 16]; AT[((dir * NGRP + g) * 64 + p) * 2] = a16.x; AT[((dir * NGRP + g) * 64 + p) * 2 + 1] = a16.y;
        }
        for (int e = F.tid; e < 2 * 16 * 64; e += 512) { const int dir = e >> 10, h = (e >> 6) & 15, p = e & 63; const size_t gi = (((size_t)(l * 2 + dir) * NGRP + g) * 16 + h) * 64 + p; CC[e] = (f2){c_re[gi], c_im[gi]}; }
        __syncthreads();
        for (int e = F.tid; e < 8192; e += 512) { const int dir = e >> 12, k = (e >> 8) & 15, h = (e >> 4) & 15, hp = e & 15; float acc = 0.f;
            for (int p = 0; p < 64; ++p) { const f2 c = CC[(dir * 16 + h) * 64 + p], a = AP[(dir * 64 + p) * 17 + k], b = BB[(dir * 64 + p) * 16 + hp];
                const float wr = c.x * a.x - c.y * a.y, wi = c.x * a.y + c.y * a.x; acc += wr * b.x - wi * b.y; }
            KT[e] = acc; }
        __syncthreads();
        for (int e = F.tid; e < 512 * 256; e += 512) { const int n = e >> 8, kk = e & 255, j = kk >> 4, hp = kk & 15; float v;
            if (n < 256) { const int i = n >> 4, h = n & 15; v = 0.f;
                if (j <= i) v += KT[((0 * 16 + (i - j)) * 16 + h) * 16 + hp];
                if (j >= i) v += KT[((1 * 16 + (j - i)) * 16 + h) * 16 + hp];
                if (i == j && h == hp) v += dskip[g * 16 + h];
            } else { const int q = n - 256, dir = q >> 7, p = q & 63, im = (q >> 6) & 1, ex = dir == 0 ? 15 - j : j; const f2 a = AP[(dir * 64 + p) * 17 + ex], b = BB[(dir * 64 + p) * 16 + hp];
                v = im ? a.x * b.y + a.y * b.x : a.x * b.x - a.y * b.y; }
            W1[((size_t)g * 512 + n) * 256 + kk] = (bf16)(cvt_pk_bf16(v, 0.f) & 0xffffu); }
        for (int e = F.tid; e < 256 * 256; e += 512) { const int n = e >> 8, kk = e & 255, i = n >> 4, h = n & 15, dir = kk >> 7, p = kk & 63, im = (kk >> 6) & 1, ex = dir == 0 ? i + 1 : 16 - i;
            const f2 c = CC[(dir * 16 + h) * 64 + p], a = AP[(dir * 64 + p) * 17 + ex]; const float wr = c.x * a.x - c.y * a.y, wi = c.x * a.y + c.y * a.x;
            W2[((size_t)g * 256 + n) * 256 + kk] = (bf16)(cvt_pk_bf16(im ? -wi : wr, 0.f) & 0xffffu); }
    }
    __syncthreads();
}
__device__ __forceinline__ void input_rows(Frame& F, const float* x0, const float* x1, bf16* o, unsigned long long* SS) {
    const int gw = F.vcu * NWAVES + F.wave, NGW = F.G * NWAVES;
    for (int row = gw; row < NTOK; row += NGW) {
        const float* xr = row < NPROMPT ? x0 + (size_t)row * DM : x1 + (size_t)(row - NPROMPT) * DM;
        f32x4 v[8]; float s = 0.f;
#pragma unroll
        for (int j = 0; j < 8; ++j) { v[j] = ((const f32x4*)xr)[F.lane + 64 * j]; s += (v[j].x * v[j].x + v[j].y * v[j].y) + (v[j].z * v[j].z + v[j].w * v[j].w); }
        s = wave_sum(s, F.lane); if (F.lane == 0) SS[row] = (unsigned long long)(s * 1048576.f + 0.5f);
#pragma unroll
        for (int j = 0; j < 8; ++j) { v2u w; w.x = cvt_pk_bf16(v[j].x, v[j].y); w.y = cvt_pk_bf16(v[j].z, v[j].w); ((v2u*)(o + (size_t)row * DM))[F.lane + 64 * j] = w; }
    }
}
__device__ __forceinline__ void final_norm(Frame& F, const bf16* X, const float* g, const unsigned long long* SS) {
    const int gw = F.vcu * NWAVES + F.wave, NGW = F.G * NWAVES;
    for (int row = gw; row < NTOK; row += NGW) {
        const v2u* xr = (const v2u*)(X + (size_t)row * DM); f32x4* orow = (f32x4*)(F.out + (size_t)row * DM);
        const float rstd = pg8::rstd_of(SS[row]);
#pragma unroll
        for (int j = 0; j < 8; ++j) { const v2u x = xr[F.lane + 64 * j]; const f32x4 gg = ((const f32x4*)g)[F.lane + 64 * j];
            f32x4 o; o.x = bf_lo(x.x) * rstd * gg.x; o.y = bf_hi(x.x) * rstd * gg.y; o.z = bf_lo(x.y) * rstd * gg.z; o.w = bf_hi(x.y) * rstd * gg.w;
            orow[F.lane + 64 * j] = o; }
    }
}
__device__ __forceinline__ void pool_prepass(Frame& F) {
    const bf16* UP = (const bf16*)(F.ws + WS_UP); bf16* PL = (bf16*)(F.ws + WS_PL);
    for (int e = F.vcu * 512 + F.tid; e < NTOK * 64; e += F.G * 512) {
        const int row = e >> 6, c8 = e & 63, gi = c8 >> 4, w = 2 << gi, lo = w >> 1, hi = (w >> 1) - 1;
        const int L = row < NPROMPT ? 2048 : 4096, pos = row & (L - 1), seq0 = row - pos;
        const int start = max(pos - lo, 0), end = min(pos + hi + 1, L);
        float a[8] = {0.f, 0.f, 0.f, 0.f, 0.f, 0.f, 0.f, 0.f};
        for (int t = start; t < end; ++t) { const v4u x = *(const v4u*)(UP + (size_t)(seq0 + t) * 512 + c8 * 8);
            a[0] += bf_lo(x.x); a[1] += bf_hi(x.x); a[2] += bf_lo(x.y); a[3] += bf_hi(x.y); a[4] += bf_lo(x.z); a[5] += bf_hi(x.z); a[6] += bf_lo(x.w); a[7] += bf_hi(x.w); }
        const float rc = 1.f / (float)(end - start); const v4u x = *(const v4u*)(UP + (size_t)row * 512 + c8 * 8);
        v4u o; o.x = cvt_pk_bf16(a[0] * rc - bf_lo(x.x), a[1] * rc - bf_hi(x.x)); o.y = cvt_pk_bf16(a[2] * rc - bf_lo(x.y), a[3] * rc - bf_hi(x.y));
        o.z = cvt_pk_bf16(a[4] * rc - bf_lo(x.z), a[5] * rc - bf_hi(x.z)); o.w = cvt_pk_bf16(a[6] * rc - bf_lo(x.w), a[7] * rc - bf_hi(x.w));
        *(v4u*)(PL + (size_t)row * 512 + c8 * 8) = o;
    }
}
__device__ __forceinline__ void ssm_scan(Frame& F) {
    const bf16* Z = (const bf16*)(F.ws + WS_Z); bf16* SP = (bf16*)(F.ws + WS_SP); const float* AT = (const float*)(F.ws + WS_AT);
    const int p = F.lane;
    for (int u = F.vcu + F.G * F.wave; u < 20 * NGRP * 2; u += F.G * NWAVES) {
        const int dir = u & 1, bg = u >> 1, g = bg & 31, b = bg >> 5;
        const int chunk0 = b < 16 ? b * 128 : 2048 + (b - 16) * 256, nch = b < 16 ? 128 : 256;
        const float ar = AT[((dir * NGRP + g) * 64 + p) * 2], ai = AT[((dir * NGRP + g) * 64 + p) * 2 + 1];
        const bf16* Zg = Z + ((size_t)g * NCHUNK + chunk0) * 256 + dir * 128 + p; bf16* Sg = SP + ((size_t)g * NCHUNK + chunk0) * 256 + dir * 128 + p;
        float sr = 0.f, si = 0.f;
        for (int c0 = 0; c0 < nch; c0 += 16) {
            float zr[16], zi[16];
#pragma unroll
            for (int k = 0; k < 16; ++k) { const int c = dir == 0 ? c0 + k : nch - 1 - (c0 + k); zr[k] = __uint_as_float((unsigned)Zg[(size_t)c * 256] << 16); zi[k] = __uint_as_float((unsigned)Zg[(size_t)c * 256 + 64] << 16); }
#pragma unroll
            for (int k = 0; k < 16; ++k) { const int c = dir == 0 ? c0 + k : nch - 1 - (c0 + k);
                Sg[(size_t)c * 256] = (bf16)(cvt_pk_bf16(sr, 0.f) & 0xffffu); Sg[(size_t)c * 256 + 64] = (bf16)(cvt_pk_bf16(si, 0.f) & 0xffffu);
                const float nr = ar * sr - ai * si + zr[k], ni = ar * si + ai * sr + zi[k]; sr = nr; si = ni; }
        }
    }
}
namespace att {
constexpr int KRING = 0, VRING = 49152;
constexpr int XOFF = 0, OSOFF = 65536, GOFF = OSOFF + 4 * 32 * 272, LDS_USED = GOFF + 512;
constexpr float THR = 8.f;
__device__ __forceinline__ int crow(int r, int hi) { return (r & 3) + 8 * (r >> 2) + 4 * hi; }
__device__ __forceinline__ int swap23(int x) { return (x & ~12) | ((x & 4) << 1) | ((x & 8) >> 1); }
__device__ __forceinline__ float swapf_max(float v) { auto rr = __builtin_amdgcn_permlane32_swap(__float_as_uint(v), __float_as_uint(v), false, false); return fmaxf(__uint_as_float(rr[0]), __uint_as_float(rr[1])); }
__device__ __forceinline__ float swapf_add(float v) { auto rr = __builtin_amdgcn_permlane32_swap(__float_as_uint(v), __float_as_uint(v), false, false); return __uint_as_float(rr[0]) + __uint_as_float(rr[1]); }
__device__ __forceinline__ bf16x8 pack_p(const f32x16& p, int s) { v4u w; w.x = cvt_pk_bf16(p[8 * s], p[8 * s + 1]); w.y = cvt_pk_bf16(p[8 * s + 2], p[8 * s + 3]); w.z = cvt_pk_bf16(p[8 * s + 4], p[8 * s + 5]); w.w = cvt_pk_bf16(p[8 * s + 6], p[8 * s + 7]); return __builtin_bit_cast(bf16x8, w); }

__device__ __forceinline__ void attn_unit(const bf16* __restrict__ Q, const bf16* __restrict__ K, const bf16* __restrict__ VT, bf16* __restrict__ O, const float* subg, float lam, int layer,
                                          int seq0, int L, int h, int qb, LAS unsigned char* lds, int wave_) {
#define FRESH_TID(t) int t; { unsigned z_ = 0u; asm volatile("" : "+v"(z_)); t = wave_ * 64 + (int)__builtin_amdgcn_mbcnt_hi(~0u, __builtin_amdgcn_mbcnt_lo(~0u, z_)); asm volatile("" : "+v"(t)); }
    FRESH_TID(tid_);
    const int wid = __builtin_amdgcn_readfirstlane(tid_ >> 6), comp = wid >> 2, wq = wid & 3;
    f32x16 o[4]; float l_run = 0.f;
    {
    const int tid = tid_, lane = tid & 63, r32 = lane & 31, hi = lane >> 5;
    unsigned koff[2], voff[2];
    const bf16* Kb = K + (size_t)seq0 * 1024 + h * 128; const bf16* Vb = VT + (size_t)(seq0 >> 8) * (1024 * 256) + (size_t)(h * 128) * 256;
#pragma unroll
    for (int i = 0; i < 2; ++i) { const int pc = wid + 8 * i;
        { const int row = (pc & 7) * 8 + (lane >> 3), c = (lane & 7) ^ ((row >> 1) & 7); koff[i] = 2u * (unsigned)(swap23(row) * 1024 + (pc >> 3) * 64 + c * 8); }
        { const int d = pc * 8 + (lane >> 3), c = (lane & 7) ^ ((d >> 1) & 7); voff[i] = 2u * (unsigned)(d * 256 + c * 8); } }
    const unsigned lds_u32 = (unsigned)(uintptr_t)lds + (unsigned)wid * 1024u;
#define DMA_K(t, slot) do { const bf16* kt_ = Kb + (size_t)(t) * 64 * 1024; asm volatile("" : "+s"(kt_));     \
        _Pragma("unroll") for (int i = 0; i < 2; ++i) pg8::glds_saddr(kt_, koff[i], lds_u32 + (unsigned)(KRING + (slot) * 16384 + i * 8192)); } while (0)
#define DMA_V(t, slot) do { const bf16* vt_ = Vb + (size_t)((t) >> 2) * (1024 * 256) + ((t) & 3) * 64; asm volatile("" : "+s"(vt_)); \
        _Pragma("unroll") for (int i = 0; i < 2; ++i) pg8::glds_saddr(vt_, voff[i], lds_u32 + (unsigned)(VRING + (slot) * 16384 + i * 8192)); } while (0)
#define WAIT_BAR() do { asm volatile("s_waitcnt vmcnt(0) lgkmcnt(0)" ::: "memory"); __builtin_amdgcn_s_barrier(); asm volatile("" ::: "memory"); } while (0)
#define WAIT_BAR_N(n) do { asm volatile("s_waitcnt vmcnt(" #n ") lgkmcnt(0)" ::: "memory"); __builtin_amdgcn_s_barrier(); asm volatile("" ::: "memory"); } while (0)
    const int NT = L / 64;
    __syncthreads();
    DMA_K(0, 0); DMA_K(1, 1); DMA_K(2, 2); DMA_V(0, 0);
    bf16x8 qf[4];
    { const bf16* qp = Q + (size_t)(seq0 + qb * 128 + wq * 32 + r32) * 1024 + h * 128 + comp * 64 + hi * 8;
#pragma unroll
      for (int s = 0; s < 4; ++s) qf[s] = *(const bf16x8*)(qp + s * 16); }
    const int sw = (r32 >> 1) & 7; const LAS unsigned char* kbs[4]; const LAS unsigned char* vbs[4];
#pragma unroll
    for (int s = 0; s < 4; ++s) { const int fo = r32 * 128 + (((2 * s + hi) ^ sw) << 4); kbs[s] = lds + KRING + comp * 8192 + fo; vbs[s] = lds + VRING + fo; }
#pragma unroll
    for (int d = 0; d < 4; ++d)
#pragma unroll
        for (int r = 0; r < 16; ++r) o[d][r] = 0.f;
    float m_run = 0.f, alpha = 1.f; bool resc = false; const float thr_ = THR;
    f32x16 pA, pB, pC, pD;
    f32x16 negm;
    v4u pw[4];
    bf16x8 kf[8];
#define SBAR() __builtin_amdgcn_sched_barrier(0)
#define PIN(x) asm volatile("" : "+v"(x))
#define USE(x) asm volatile("" :: "v"(x))
#define SGB(mask, n) __builtin_amdgcn_sched_group_barrier((mask), (n), 0)
#define KFR(kh, s) (*(const LAS bf16x8*)(kbs[s] + (kb_ + (kh) * 4096)))
#define VFR(d, s) (*(const LAS bf16x8*)(vbs[s] + (vb_ + (d) * 4096)))
#define MFMA32(a, b, c) __builtin_amdgcn_mfma_f32_32x32x16_bf16((a), (b), (c), 0, 0, 0)
#define GAPA(C, CIN, kh, s, P, B, W) do { C = MFMA32(kf[(s) * 2 + (kh)], qf[s], CIN); PIN(C); \
        pw[W][((B) >> 1) & 3] = cvt_pk_bf16(P[B], P[B + 1]); pw[W][(((B) >> 1) & 3) + 1] = cvt_pk_bf16(P[B + 2], P[B + 3]); \
        l_run += P[B]; l_run += P[B + 1]; l_run += P[B + 2]; l_run += P[B + 3]; USE(l_run); SBAR(); } while (0)
#define PVM(d, s) o[d] = MFMA32(vf[((d) & 1) * 4 + (s)], __builtin_bit_cast(bf16x8, pw[s]), o[d])
#define MAXF(X, B) "v"(X[B]), "v"(X[B + 1]), "v"(X[B + 2]), "v"(X[B + 3]), "v"(X[B + 4]), "v"(X[B + 5]), "v"(X[B + 6]), "v"(X[B + 7])
#define GAPM_FIRST(d, s, X, B) do { PVM(d, s); asm("v_max3_f32 %0, %2, %3, %4\n\tv_max3_f32 %1, %5, %6, %7\n\tv_max3_f32 %0, %0, %8, %9" : "=&v"(mxa), "=&v"(mxb) : MAXF(X, B)); SBAR(); } while (0)
#define GAPM(d, s, X, B) do { PVM(d, s); asm("v_max3_f32 %0, %0, %2, %3\n\tv_max3_f32 %1, %1, %4, %5\n\tv_max3_f32 %0, %0, %6, %7\n\tv_max3_f32 %1, %1, %8, %9" : "+v"(mxa), "+v"(mxb) : MAXF(X, B)); SBAR(); } while (0)
#define GAPM_LAST(d, s, X, B) do { PVM(d, s); asm("v_max3_f32 %0, %0, %3, %4\n\tv_max3_f32 %1, %1, %5, %6\n\tv_max3_f32 %0, %0, %7, %8\n\tv_max3_f32 %1, %1, %9, %10\n\tv_max_f32 %0, %0, %1\n\tv_cmp_nle_f32 %2, %0, %11" \
        : "+v"(mxa), "+v"(mxb), "=s"(over) : MAXF(X, B), "s"(thr_)); SBAR(); } while (0)
#define GAPE3(d, s, X, B) do { PVM(d, s); X[B] = __builtin_amdgcn_exp2f(X[B]); X[B + 1] = __builtin_amdgcn_exp2f(X[B + 1]); X[B + 2] = __builtin_amdgcn_exp2f(X[B + 2]); PIN(X); SBAR(); } while (0)
#define GAPE2(d, s, X, B) do { PVM(d, s); X[B] = __builtin_amdgcn_exp2f(X[B]); X[B + 1] = __builtin_amdgcn_exp2f(X[B + 1]); PIN(X); SBAR(); } while (0)
#define DECIDE(C0, C1) do { resc = false; \
        if (__builtin_expect(over != 0ull, 0)) { const float mx = swapf_max(mxa); const float dl = fmaxf(mx, 0.f); alpha = __builtin_amdgcn_exp2f(-dl); m_run += dl; l_run *= alpha; resc = true; \
            _Pragma("unroll") for (int r = 0; r < 16; ++r) { C0[r] -= dl; C1[r] -= dl; negm[r] -= dl; } } } while (0)
#define RESCALE() do { if (resc) { _Pragma("unroll") for (int d = 0; d < 4; ++d) _Pragma("unroll") for (int r = 0; r < 16; ++r) o[d][r] *= alpha; } } while (0)
#define KPRE2(kslot, s0) do { constexpr int kb_ = (kslot) * 16384; _Pragma("unroll") for (int s = (s0); s < (s0) + 2; ++s) { kf[2 * s] = KFR(0, s); kf[2 * s + 1] = KFR(1, s); } } while (0)
#define PHASE_A(C0, C1, P0, P1, vslot) do { \
        constexpr int vb_ = (vslot) * 16384; \
        SBAR(); \
        GAPA(C0, negm, 0, 0, P0, 0, 0); GAPA(C1, negm, 1, 0, P0, 4, 0); \
        GAPA(C0, C0, 0, 1, P0, 8, 1); GAPA(C1, C1, 1, 1, P0, 12, 1); \
        GAPA(C0, C0, 0, 2, P1, 0, 2); GAPA(C1, C1, 1, 2, P1, 4, 2); \
        _Pragma("unroll") for (int s = 0; s < 4; ++s) vf[s] = VFR(0, s); SBAR();        \
        GAPA(C0, C0, 0, 3, P1, 8, 3); GAPA(C1, C1, 1, 3, P1, 12, 3); \
        } while (0)
#define PHASE_B(C0, C1, vslot, knext, pre) do { \
        constexpr int vb_ = (vslot) * 16384; \
        _Pragma("unroll") for (int s = 0; s < 4; ++s) vf[4 + s] = VFR(1, s); \
        float mxa, mxb; unsigned long long over; asm volatile("s_nop 15\n\ts_nop 7" : "+v"(C0), "+v"(C1)); SBAR(); \
        GAPM_FIRST(0, 0, C0, 0); GAPM(0, 1, C0, 8); GAPM(0, 2, C1, 0); GAPM_LAST(0, 3, C1, 8); \
        DECIDE(C0, C1); \
        _Pragma("unroll") for (int s = 0; s < 4; ++s) vf[s] = VFR(2, s); SBAR(); \
        GAPE3(1, 0, C0, 0); GAPE3(1, 1, C0, 3); GAPE3(1, 2, C0, 6); GAPE3(1, 3, C0, 9); \
        _Pragma("unroll") for (int s = 0; s < 4; ++s) vf[4 + s] = VFR(3, s); if (pre) KPRE2(knext, 0); SBAR(); \
        GAPE3(2, 0, C0, 12); C0[15] = __builtin_amdgcn_exp2f(C0[15]); GAPE3(2, 1, C1, 0); if (pre) KPRE2(knext, 2); SBAR(); GAPE3(2, 2, C1, 3); GAPE3(2, 3, C1, 6); \
        GAPE3(3, 0, C1, 9); GAPE2(3, 1, C1, 12); GAPE2(3, 2, C1, 14); PVM(3, 3); SBAR(); \
        RESCALE(); } while (0)
#define BOUNDARY(t, S0, SN) do { if ((t) + 2 < NT) WAIT_BAR_N(4); else WAIT_BAR_N(2); \
        if ((t) + 3 < NT) DMA_K((t) + 3, S0); if ((t) + 1 < NT) DMA_V((t) + 1, SN); } while (0)
#define STEP(C0, C1, P0, P1, t, S0, S1, SN) do { BOUNDARY((t), S0, SN); bf16x8 vf[8]; PHASE_A(C0, C1, P0, P1, S1); PHASE_B(C0, C1, S1, SN, ((t) + 1 < NT)); } while (0)
    WAIT_BAR();
    KPRE2(0, 0); KPRE2(0, 2);
    WAIT_BAR_N(0);
    DMA_K(3, 0); DMA_V(1, 1);
    {
#pragma unroll
      for (int r = 0; r < 16; ++r) { pA[r] = 0.f; pB[r] = 0.f; }
#pragma unroll
      for (int s = 0; s < 4; ++s) { pA = MFMA32(kf[2 * s], qf[s], pA); pB = MFMA32(kf[2 * s + 1], qf[s], pB); }
      SBAR(); KPRE2(1, 0); KPRE2(1, 2);
      float mx = fmaxf(pA[0], pB[0]);
#pragma unroll
      for (int r = 1; r < 16; ++r) mx = fmaxf(mx, fmaxf(pA[r], pB[r]));
      m_run = swapf_max(mx);
#pragma unroll
      for (int r = 0; r < 16; ++r) { pA[r] = __builtin_amdgcn_exp2f(pA[r] - m_run); pB[r] = __builtin_amdgcn_exp2f(pB[r] - m_run); negm[r] = -m_run; } }
    if (comp == 1) __builtin_amdgcn_s_setprio(1);
    int t = 1;
    for (; t + 6 < NT; t += 6) {
        STEP(pC, pD, pA, pB, t, 1, 0, 2); STEP(pA, pB, pC, pD, t + 1, 2, 1, 0); STEP(pC, pD, pA, pB, t + 2, 0, 2, 1);
        STEP(pA, pB, pC, pD, t + 3, 1, 0, 2); STEP(pC, pD, pA, pB, t + 4, 2, 1, 0); STEP(pA, pB, pC, pD, t + 5, 0, 2, 1); }
    if (NT == 64) { STEP(pC, pD, pA, pB, 61, 1, 0, 2); STEP(pA, pB, pC, pD, 62, 2, 1, 0); STEP(pC, pD, pA, pB, 63, 0, 2, 1); }
    else { STEP(pC, pD, pA, pB, 31, 1, 0, 2); }
    __builtin_amdgcn_s_setprio(0);
    WAIT_BAR();
    const int vs_last = (NT == 64) ? 0 : 1;
    { const int vb_ = vs_last * 16384;
      float sacc = 0.f;
#pragma unroll
      for (int r = 0; r < 16; ++r) sacc += pC[r] + pD[r];
      l_run += sacc;
      bf16x8 pa[4]; pa[0] = pack_p(pC, 0); pa[1] = pack_p(pC, 1); pa[2] = pack_p(pD, 0); pa[3] = pack_p(pD, 1);
#pragma unroll
      for (int d = 0; d < 4; ++d)
#pragma unroll
          for (int s = 0; s < 4; ++s) o[d] = __builtin_amdgcn_mfma_f32_32x32x16_bf16(VFR(d, s), pa[s], o[d], 0, 0, 0); }
#undef DMA_K
#undef DMA_V
#undef STEP
#undef BOUNDARY
#undef PHASE_A
#undef PHASE_B
#undef KPRE2
#undef GAPA
#undef GAPM
#undef MAXF
#undef GAPM_FIRST
#undef GAPM_LAST
#undef GAPE3
#undef GAPE2
#undef PVM
#undef DECIDE
#undef RESCALE
#undef PIN
#undef USE
#undef SGB
#undef KFR
#undef VFR
    }
    WAIT_BAR();
    FRESH_TID(te_);
#undef FRESH_TID
    const int tid = te_, lane = tid & 63, r32 = lane & 31, hi = lane >> 5;
    const float inv = 1.f / swapf_add(l_run);
    LAS float* X = (LAS float*)(lds + XOFF); LAS float* Gt = (LAS float*)(lds + GOFF);
    if (comp == 1) { const float f = lam * inv;
#pragma unroll
        for (int d = 0; d < 4; ++d)
#pragma unroll
            for (int r = 0; r < 16; ++r) X[(wq * 128 + 32 * d + crow(r, hi)) * 32 + r32] = o[d][r] * f; }
    { int l_ = layer; asm volatile("" : "+s"(l_)); if (tid < 128) Gt[tid] = subg[tid] * (1.f - (0.8f - 0.6f * __expf(-0.3f * (float)l_))); }
    __syncthreads();
    if (comp == 0) {
        float ss = 0.f;
#pragma unroll
        for (int d = 0; d < 4; ++d)
#pragma unroll
            for (int r = 0; r < 16; ++r) { const float v = o[d][r] * inv - X[(wq * 128 + 32 * d + crow(r, hi)) * 32 + r32]; o[d][r] = v; ss += v * v; }
        ss = swapf_add(ss);
        const float rs = rsqrtf(ss * (1.f / 128.f) + RMS_EPS);
        LAS unsigned char* os = lds + OSOFF + wq * (32 * 272);
#pragma unroll
        for (int d = 0; d < 4; ++d)
#pragma unroll
            for (int rg = 0; rg < 4; ++rg) { const int d0 = 32 * d + 8 * rg + 4 * hi; const f32x4 gg = *(const LAS f32x4*)(Gt + d0);
                v2u w; w.x = cvt_pk_bf16(o[d][4 * rg] * rs * gg.x, o[d][4 * rg + 1] * rs * gg.y); w.y = cvt_pk_bf16(o[d][4 * rg + 2] * rs * gg.z, o[d][4 * rg + 3] * rs * gg.w);
                *(LAS v2u*)(os + r32 * 272 + d0 * 2) = w; }
        LDS_WAIT(); asm volatile("" ::: "memory");
        bf16* Ow = O + (size_t)(seq0 + qb * 128 + wq * 32) * DM + h * 128;
#pragma unroll
        for (int i = 0; i < 8; ++i) { const int cid = lane + 64 * i, row = cid >> 4, c16 = cid & 15; const v4u v = *(const LAS v4u*)(os + row * 272 + c16 * 16); *(v4u*)(Ow + (size_t)row * DM + c16 * 8) = v; }
    }
}
struct APtrs { const float *q1, *k1, *q2, *k2, *subln; };
__device__ __forceinline__ void attn_phase(Frame& F, const APtrs& A, int l) {
    const bf16* Q = (const bf16*)(F.ws + WS_Q); const bf16* K = (const bf16*)(F.ws + WS_K); const bf16* VT = (const bf16*)(F.ws + WS_VT); bf16* MIX = (bf16*)(F.ws + WS_HB);
    const float lam_init = 0.8f - 0.6f * expf(-0.3f * (float)l);
    float d1 = 0.f, d2 = 0.f;
    for (int i = 0; i < 64; ++i) { d1 += A.q1[l * 64 + i] * A.k1[l * 64 + i]; d2 += A.q2[l * 64 + i] * A.k2[l * 64 + i]; }
    const float lam = __builtin_bit_cast(float, __builtin_amdgcn_readfirstlane(__builtin_bit_cast(int, expf(d1) - expf(d2) + lam_init)));
    const float* subg = A.subln + l * 128;
    for (int U = F.vcu; U < 1024; U += F.G) { const int bh = U >> 5, qb = U & 31, b = bh >> 3, h = bh & 7; attn_unit(Q, K, VT, MIX, subg, lam, l, NPROMPT + b * 4096, 4096, h, qb, F.lds, F.wave); }
    for (int U = F.vcu; U < 2048; U += F.G) { const int bh = U >> 4, qb = U & 15, b = bh >> 3, h = bh & 7; attn_unit(Q, K, VT, MIX, subg, lam, l, b * 2048, 2048, h, qb, F.lds, F.wave); }
    __syncthreads();
}
}
#ifndef UP_ALIGN
#define UP_ALIGN true
#endif
#ifndef FFN_SP2
#define FFN_SP2 true
#endif
constexpr int NSLAB = 6, SLAB_ROWS = NTOK / NSLAB  , SLAB_PANELS = SLAB_ROWS / 256;
constexpr int PH_PER_LAYER = 7 + NSLAB + 1, NPHASE = 1 + NLAYER * PH_PER_LAYER + 1;
struct Args { const float* in[26]; float* out; unsigned char* ws; int ph_lo, ph_hi, use_bar, pad; };
typedef __attribute__((address_space(4))) const unsigned char* KP;
template <class T> __device__ __forceinline__ T karg(KP kp, int off) { typedef T TT; return *(const __attribute__((address_space(4))) TT*)(kp + off); }
#define KARG(T, off) karg<T>(kp, (off))
__global__ void __launch_bounds__(NWAVES * 64, 2) fwd_kernel(Args args) {
    extern __shared__ __attribute__((aligned(16))) unsigned char lds_raw[];
    Frame F;
    F.lds = (LAS unsigned char*)lds_raw;
    F.tid = threadIdx.x; F.lane = F.tid & 63; F.wave = __builtin_amdgcn_readfirstlane(F.tid >> 6);
    F.G = gridDim.x; { const int bx = blockIdx.x; F.vcu = (F.G % 8 == 0) ? (bx % 8) * (F.G / 8) + bx / 8 : bx; }
    KP kp0 = (KP)__builtin_amdgcn_kernarg_segment_ptr();
    static_assert(sizeof(Args) == 240, "Args layout");
    F.out = nullptr; F.ws = nullptr;
    volatile LAS unsigned* MISC = (volatile LAS unsigned*)(F.lds + MISC_OFF);
    for (int u = F.tid; u < (LDS_BYTES - LDSCTL_OFF) / 4; u += NWAVES * 64) ((LAS unsigned*)(F.lds + LDSCTL_OFF))[u] = 0u;
    __syncthreads();
    KP kp = kp0; asm volatile("" : "+s"(kp));
    unsigned* barw = (unsigned*)(KARG(unsigned char*, 216) + WS_CTL) + CW_BAR;
    XcdBarrier bar; bar.bar = barw; bar.x = 0; bar.st = nullptr;
    if (KARG(int, 232)) bar = xcd_barrier_post(barw, MISC + 8);
    const int lo = KARG(int, 224), hi = KARG(int, 228);
#define IN(k) (lo <= (k) && (k) < hi)
#define SEAM(k) do { if (IN(k) && IN((k) + 1)) xcd_barrier(bar); } while (0)
#define PHASE_FRAME() Frame P; KP kp = kp0; { int g_ = __builtin_amdgcn_readfirstlane(F.G), v_ = __builtin_amdgcn_readfirstlane(F.vcu), w_ = F.wave, c_ = __builtin_amdgcn_readfirstlane((int)blockIdx.x); \
        asm volatile("" : "+s"(kp), "+s"(g_), "+s"(v_), "+s"(w_), "+s"(c_)); \
        unsigned z_ = 0u; asm volatile("" : "+v"(z_)); int t_ = w_ * 64 + (int)__builtin_amdgcn_mbcnt_hi(~0u, __builtin_amdgcn_mbcnt_lo(~0u, z_)); asm volatile("" : "+v"(t_)); \
        P.out = KARG(float*, 208); P.ws = KARG(unsigned char*, 216); P.G = g_; P.vcu = v_; P.tid = t_; P.lane = t_ & 63; P.wave = w_; P.lds = F.lds; cblk = c_; } \
        LAS unsigned char* ring = P.lds
#define AIN(k) KARG(const float*, 8 * (k))
#define WPTRS() WPtrs WP{AIN(3), AIN(21), AIN(17), AIN(19), AIN(20), AIN(23), AIN(24), AIN(2), AIN(22)}
#define SPTRS() SPtrs SS{AIN(9), AIN(10), AIN(11), AIN(12), AIN(13), AIN(14), AIN(15), AIN(16)}
#define WSP(T, off) ((T*)(P.ws + (off)))
#define SS1(l) (WSP(unsigned long long, WS_SS) + (size_t)(l) * NTOK)
#define SS2(l) (WSP(unsigned long long, WS_SS) + (size_t)(5 + (l)) * NTOK)
#define X1P ((bf16*)P.out)
#define X2P ((bf16*)P.out + (size_t)NTOK * DM)
    int cblk = 0;
    if (IN(0)) { PHASE_FRAME(); (void)ring; WPTRS(); SPTRS();
        if (P.G >= 2 * NGRP) { if (cblk >= NGRP) convert_weights(P, WP, 0, 7, cblk - NGRP, P.G - NGRP); else ssm_weights(P, SS, 0); __syncthreads(); }
        else { convert_weights(P, WP, 0, 7, cblk, P.G); __syncthreads(); ssm_weights(P, SS, 0); }
        input_rows(P, AIN(0), AIN(1), X1P, SS1(0));
        SEAM(0);
    }
    for (int l = 0; l < NLAYER; ++l) {
        const int pb = 1 + l * PH_PER_LAYER;
        if (IN(pb + 0)) { PHASE_FRAME();
            int cfirst = ((cblk >> 3) & 1) == 0 ? 1 : 0; asm volatile("" : "+s"(cfirst));
            if (l > 0 && cfirst) { WPTRS(); convert_weights(P, WP, l, 2, cblk, P.G); __syncthreads(); }
            { pg8::Gemm g{X1P, WSP(bf16, WS_WIN), NTOK, 3072, DM}; pg8::SchedX<1> S; S.init(NTOK, 3072, P.G, cblk); S.off = 0;
              pg8::EpiInProj E{WSP(bf16, WS_Q), WSP(bf16, WS_K), WSP(bf16, WS_US), WSP(bf16, WS_UP), WSP(const float, WS_ROPE), SS1(l)};
              pg8::gemm_phase<pg8::EpiInProj, pg8::SchedX<1>, true, true>(ring, g, S, E, P.tid); }
            { pg8::Gemm g{WSP(bf16, WS_WIN) + (size_t)2048 * DM, X1P, 1024, NTOK, DM}; pg8::SchedX<0> S; S.init(1024, NTOK, P.G, cblk); S.off = 0;
              pg8::EpiVT E{WSP(bf16, WS_VT), SS1(l)};
              pg8::gemm_phase<pg8::EpiVT, pg8::SchedX<0>, true, true>(ring, g, S, E, P.tid); }
            if (l > 0 && !cfirst) { KP kp2 = kp0; asm volatile("" : "+s"(kp2)); KP kp = kp2; WPTRS(); convert_weights(P, WP, l, 2, cblk, P.G); __syncthreads(); }
            SEAM(pb + 0);
        }
        if (IN(pb + 1)) { PHASE_FRAME(); int kssm = 256; asm volatile("" : "+s"(kssm));
            { pg8::Gemm g{WSP(bf16, WS_US), WSP(bf16, WS_SSM1), NGRP * NCHUNK, 512, kssm}; pg8::SchedX<2> S; S.init(NGRP * NCHUNK, 512, P.G, cblk); S.off = 0;
              pg8::EpiSsm1 E{WSP(bf16, WS_YI), (size_t)(WS_Z - WS_YI) / 2};
              pg8::gemm_phase<pg8::EpiSsm1, pg8::SchedX<2>, true, true>(ring, g, S, E, P.tid); }
            SEAM(pb + 1);
        }
        if (IN(pb + 2)) { PHASE_FRAME(); (void)ring; ssm_scan(P); pool_prepass(P); SEAM(pb + 2); }
        if (IN(pb + 3)) { PHASE_FRAME(); int kssm = 256; asm volatile("" : "+s"(kssm));
            { pg8::Gemm g{WSP(bf16, WS_SP), WSP(bf16, WS_SSM2), NGRP * NCHUNK, 256, kssm}; pg8::SchedX<3> S; S.init(NGRP * NCHUNK, 256, P.G, cblk); S.off = 0;
              pg8::EpiSsm2 E{WSP(bf16, WS_YI), WSP(bf16, WS_ZB)};
              pg8::gemm_phase<pg8::EpiSsm2, pg8::SchedX<3>, true, true>(ring, g, S, E, P.tid); }
            SEAM(pb + 3);
        }
        if (IN(pb + 4)) { PHASE_FRAME();
            { pg8::Gemm g{WSP(bf16, WS_ZB), WSP(bf16, WS_GP), 2 * NTOK, 1024, 512}; pg8::SchedX<4> S; S.init(NTOK, 1024, P.G, cblk); S.off = 0;
              pg8::EpiGluPool E{WSP(bf16, WS_ZB), AIN(18) + (size_t)l * 512, WSP(bf16, WS_HB)};
              pg8::gemm_phase<pg8::EpiGluPool, pg8::SchedX<4>, true, true>(ring, g, S, E, P.tid); }
            if (!IN(pb + 5)) SEAM(pb + 4);
        }
        if (IN(pb + 5)) { PHASE_FRAME(); (void)ring; att::APtrs AP{AIN(4), AIN(5), AIN(6), AIN(7), AIN(8)}; att::attn_phase(P, AP, l); SEAM(pb + 5); }
        if (IN(pb + 6)) { PHASE_FRAME();
            { pg8::Gemm g{WSP(bf16, WS_HB), WSP(bf16, WS_WOUT), NTOK, DM, DM}; pg8::SchedX<0> S; S.init(NTOK, DM, P.G, cblk); S.off = 0;
              pg8::EpiResidX E{X1P, X2P, SS2(l), 0};
              pg8::gemm_phase<pg8::EpiResidX, pg8::SchedX<0>, true, true>(ring, g, S, E, P.tid); }
            SEAM(pb + 6);
        }
        for (int s = 0; s <= NSLAB; ++s) {
            if (IN(pb + 7 + s)) { PHASE_FRAME();
                if (s == 0 && l + 1 < NLAYER) { WPTRS(); SPTRS();
                    if (P.G >= 2 * NGRP) { if (cblk >= NGRP) convert_weights(P, WP, l + 1, 1, cblk - NGRP, P.G - NGRP); else ssm_weights(P, SS, l + 1); __syncthreads(); }
                    else { convert_weights(P, WP, l + 1, 1, cblk, P.G); __syncthreads(); ssm_weights(P, SS, l + 1); __syncthreads(); } }
                const int par = 0;
#pragma unroll 1
                for (int k = 0; k < 2; ++k) { int kk = k ^ par; asm volatile("" : "+s"(kk));
                    if (kk == 0) { if (s > 0) { const int sd = s - 1;
                        pg8::Gemm g{WSP(bf16, WS_HID) + (size_t)(sd & 1) * ((size_t)SLAB_ROWS * DFF), WSP(bf16, WS_WDN), SLAB_ROWS, DM, DFF}; pg8::SchedX<0> S; S.init(SLAB_ROWS, DM, P.G, cblk); S.off = 0;
                        pg8::EpiResidX E{X2P, l + 1 < NLAYER ? X1P : WSP(bf16, WS_HB), SS1(l + 1), sd * SLAB_ROWS};
                        pg8::gemm_phase<pg8::EpiResidX, pg8::SchedX<0>, true, FFN_SP2>(ring, g, S, E, P.tid); } }
                    else { if (s < NSLAB) {
                        pg8::Gemm g{X2P, WSP(bf16, WS_WUP), NTOK, DFF, DM}; pg8::SchedX<0> S; S.init(SLAB_ROWS, DFF, P.G, cblk); S.off = s * SLAB_PANELS;
                        pg8::EpiSqRelu E{WSP(bf16, WS_HID) + (size_t)(s & 1) * ((size_t)SLAB_ROWS * DFF), s * SLAB_ROWS, SS2(l)};
                        pg8::gemm_phase<pg8::EpiSqRelu, pg8::SchedX<0>, UP_ALIGN, FFN_SP2>(ring, g, S, E, P.tid); } }
                }
                SEAM(pb + 7 + s);
            }
        }
    }
    if (IN(NPHASE - 1)) { PHASE_FRAME(); (void)ring; final_norm(P, WSP(bf16, WS_HB), AIN(25), SS1(NLAYER)); }
#undef IN
#undef SEAM
}

#ifndef MK_ONE_LAUNCH
#define MK_ONE_LAUNCH 1
#endif
extern "C" void kernel_launch(void* const* d_in, const int* in_sizes, int n_in, void* d_out, int out_size, void* d_ws, size_t ws_size, hipStream_t stream) {
    static int grid = 0;
    if (grid == 0) {
        if (n_in != 26 || out_size != NTOK * DM || ws_size < WS_END) { fprintf(stderr, "kernel_launch: unexpected shapes: n_in %d out %d ws %zu (need %zu)\n", n_in, out_size, ws_size, (size_t)WS_END); grid = -1; return; }
        int dev = 0, cus = 0, per_cu = 0;
        if (hipGetDevice(&dev) != hipSuccess || hipDeviceGetAttribute(&cus, hipDeviceAttributeMultiprocessorCount, dev) != hipSuccess) { grid = -1; return; }
        if (hipFuncSetAttribute((const void*)fwd_kernel, hipFuncAttributeMaxDynamicSharedMemorySize, LDS_BYTES) != hipSuccess) { fprintf(stderr, "kernel_launch: hipFuncSetAttribute failed\n"); grid = -1; return; }
        if (hipOccupancyMaxActiveBlocksPerMultiprocessor(&per_cu, (const void*)fwd_kernel, NWAVES * 64, LDS_BYTES) != hipSuccess || per_cu < 1) fprintf(stderr, "kernel_launch: occupancy query reports %d\n", per_cu);
        (void)hipGetLastError();
        grid = cus;
    }
    if (grid < 0) return;
    if (hipMemsetAsync((char*)d_ws + WS_CTL, 0, CTL_ZERO_BYTES, stream) != hipSuccess) return;
    if (hipMemsetAsync((char*)d_ws + WS_SS, 0, SS_BYTES, stream) != hipSuccess) return;
    Args a{};
    for (int i = 0; i < 26; ++i) a.in[i] = (const float*)d_in[i];
    a.out = (float*)d_out; a.ws = (unsigned char*)d_ws; a.pad = 0;
#if MK_ONE_LAUNCH
    a.ph_lo = 0; a.ph_hi = NPHASE; a.use_bar = 1;
    hipLaunchKernelGGL(fwd_kernel, dim3(grid), dim3(NWAVES * 64), LDS_BYTES, stream, a);
#else
    a.use_bar = 0;
    for (int p = 0; p < NPHASE; ++p) { a.ph_lo = p; a.ph_hi = p + 1; hipLaunchKernelGGL(fwd_kernel, dim3(grid), dim3(NWAVES * 64), LDS_BYTES, stream, a); }
#endif
    const hipError_t le = hipPeekAtLastError();
    if (le != hipSuccess) fprintf(stderr, "kernel_launch: launch failed: %s\n", hipGetErrorName(le));
}
```

```cpp
#include <hip/hip_runtime.h>
#include <hip/hip_bf16.h>
#include <cstdio>
#include <cstdint>
#include <cmath>
constexpr int DM = 2048, NTOK = 49152, NPROMPT = 32768, NLAYER = 4, DFF = 8192;
constexpr int CH_T = 16, NCHUNK = NTOK / CH_T  , NGRP = 32;
constexpr float QSCALE = 0.125f * 1.4426950408889634f;
constexpr float RMS_EPS = 1e-6f;

namespace pg8 {
#define PG8_LAS __attribute__((address_space(3)))
typedef unsigned short bf16_t;
typedef short bf16x8 __attribute__((ext_vector_type(8)));
typedef float f32x4 __attribute__((ext_vector_type(4)));
typedef unsigned u32x4 __attribute__((ext_vector_type(4)));
constexpr int BM = 256, BK = 64, HALF = 128, HTB = HALF * BK * 2  , STAGE_BYTES = 8 * HTB, NXCD = 8, WGM = 8;

__device__ __forceinline__ void glds_saddr(const void* sbase, unsigned voff, unsigned lds_addr) {
    asm volatile("s_mov_b32 m0, %2\n\ts_nop 3\n\tglobal_load_lds_dwordx4 %0, %1" :: "v"(voff), "s"(sbase), "s"(lds_addr) : "memory");
}
__host__ __device__ __forceinline__ int lds_byte(int r, int c) { const int st = (r >> 4) * 2 + (c >> 5), rr = r & 15, cc = c & 31, ob = rr * 64 + cc * 2; return st * 1024 + (ob ^ (((ob >> 9) & 1) << 5)); }
__host__ __device__ __forceinline__ void stage_rc(int b, int& R, int& C) { const int st = b / 1024, sb = b % 1024, swz = sb ^ (((sb >> 9) & 1) << 5); R = (st >> 1) * 16 + swz / 64; C = (st & 1) * 32 + (swz % 64) / 2; }
__host__ __device__ __forceinline__ int perm32(int rho) { const int n = rho >> 4, i = rho & 15; return 8 * (i >> 2) + 4 * n + (i & 3); }

struct Unit { int pm, pn; };
struct Gemm { const bf16_t* A; const bf16_t* Bt; int M, N, K; };

struct StaticOrder {
    int nM, nN, nwg, G, c;
    __host__ __device__ void init(int M, int N, int G_, int c_) { nM = M / BM; nN = N / BM; nwg = nM * nN; G = G_; c = c_; }
    __host__ __device__ bool next(int i, Unit& u) const {
        const long L = (long)i * G + c; if (L >= nwg) return false;
        int wgid = (int)L; { const int q = nwg / NXCD, r = nwg % NXCD, xcd = wgid % NXCD, off = wgid / NXCD; wgid = (xcd < r ? xcd * (q + 1) : r * (q + 1) + (xcd - r) * q) + off; }
        const int nig = WGM * nN, gid = wgid / nig, fm = gid * WGM, gsz = (nM - fm) < WGM ? (nM - fm) : WGM;
        u.pm = fm + ((wgid % nig) % gsz); u.pn = (wgid % nig) / gsz; return true;
    }
    __device__ __forceinline__ void a_ready(const Unit&) const {}
    __device__ __forceinline__ void done(const Unit&) const {}
};
template <int MODE> struct SchedX : StaticOrder {
    int off;
    __device__ __forceinline__ bool next(int i, Unit& u) const {
        if (!StaticOrder::next(i, u)) return false;
        if (MODE == 0) u.pm += off;
        if (MODE == 1) u.pn = u.pn < 8 ? u.pn : u.pn + 4;
        if (MODE == 2) u.pn = (u.pm / 12) * 2 + u.pn;
        if (MODE == 3) u.pn = u.pm / 12;
        if (MODE == 4) { if (u.pn >= 2) u.pm += 192; }
        return true;
    }
};

typedef float f32x2 __attribute__((ext_vector_type(2))); typedef __bf16 bf16x2_t __attribute__((ext_vector_type(2))); typedef unsigned u32x2 __attribute__((ext_vector_type(2)));
__device__ __forceinline__ unsigned cvt_pk_bf16(float lo, float hi) { f32x2 v = {lo, hi}; bf16x2_t b = __builtin_convertvector(v, bf16x2_t); return __builtin_bit_cast(unsigned, b); }
__device__ __forceinline__ float sum_xor16(float v) { auto r = __builtin_amdgcn_permlane16_swap(__float_as_uint(v), __float_as_uint(v), false, false); return __uint_as_float(r[0]) + __uint_as_float(r[1]); }
__device__ __forceinline__ float sum_xor32(float v) { auto r = __builtin_amdgcn_permlane32_swap(__float_as_uint(v), __float_as_uint(v), false, false); return __uint_as_float(r[0]) + __uint_as_float(r[1]); }
__device__ __forceinline__ float get_xor16(float v, bool odd_row) { auto r = __builtin_amdgcn_permlane16_swap(__float_as_uint(v), __float_as_uint(v), false, false); return __uint_as_float(odd_row ? r[0] : r[1]); }
__device__ __forceinline__ float bf_lo(unsigned w) { return __uint_as_float(w << 16); }
__device__ __forceinline__ float bf_hi(unsigned w) { return __uint_as_float(w & 0xffff0000u); }
__device__ __forceinline__ u32x4 pack8(f32x4 a, f32x4 b) { u32x4 w; w.x = cvt_pk_bf16(a[0], a[1]); w.y = cvt_pk_bf16(a[2], a[3]); w.z = cvt_pk_bf16(b[0], b[1]); w.w = cvt_pk_bf16(b[2], b[3]); return w; }

__device__ __forceinline__ float rstd_of(unsigned long long ss) { return __builtin_amdgcn_rsqf((float)ss * (1.f / (1048576.f * DM)) + RMS_EPS); }
struct EpiVT { static constexpr bool PERM = true, AFTER_DRAIN = false; static constexpr bool PERM2 = false; static constexpr int NVM = 16;
    bf16_t* O; const unsigned long long* SS;
    __device__ __forceinline__ void operator()(const f32x4 (&acc)[2][2][4][2], const Unit& u, int wr, int wc, int fr, int fq) const {
        asm volatile("" : "+v"(fr), "+v"(fq));
        const int row0 = u.pm * BM + wr * 64 + fr, cl0 = wc * 32 + 8 * fq, col0 = u.pn * BM + cl0;
        f32x4 r0[2], r1[2];
#pragma unroll
        for (int bj = 0; bj < 2; ++bj)
#pragma unroll
            for (int i = 0; i < 4; ++i) { r0[bj][i] = rstd_of(SS[col0 + bj * HALF + i]); r1[bj][i] = rstd_of(SS[col0 + bj * HALF + 4 + i]); }
        bf16_t* tile = O + (size_t)u.pn * (1024 * 256);
#pragma unroll
        for (int ai = 0; ai < 2; ++ai)
#pragma unroll
            for (int m = 0; m < 4; ++m) { bf16_t* rowp = tile + (size_t)(row0 + ai * HALF + m * 16) * 256 + cl0;
#pragma unroll
                for (int bj = 0; bj < 2; ++bj) *(u32x4*)(rowp + bj * HALF) = pack8(acc[ai][bj][m][0] * r0[bj], acc[ai][bj][m][1] * r1[bj]); }
    }
};
struct EpiInProj { static constexpr bool PERM = true, AFTER_DRAIN = false; static constexpr bool PERM2 = false; static constexpr int NVM = 16;
    bf16_t *Q, *K, *US, *UP; const float* rope; const unsigned long long* SS;
    __device__ __forceinline__ void operator()(const f32x4 (&acc)[2][2][4][2], const Unit& u, int wr, int wc, int fr, int fq) const {
        asm volatile("" : "+v"(fr), "+v"(fq));
        const int pn = u.pn, row0 = u.pm * BM + wr * 64 + fr, cw = wc * 32 + 8 * fq;
        if (pn < 8) {
            bf16_t* base = pn < 4 ? Q : K; const int colt = (pn & 3) * BM; const float sc = pn < 4 ? QSCALE : 1.f;
            const bool ropew = (wc & 1) == 0;
#pragma unroll
            for (int ai = 0; ai < 2; ++ai)
#pragma unroll
                for (int m = 0; m < 4; ++m) { const int row = row0 + ai * HALF + m * 16; const int pos = row < NPROMPT ? (row & 2047) : (row & 4095); const float rstd = rstd_of(SS[row]);
                    f32x4 c0 = {1.f, 1.f, 1.f, 1.f}, c1 = c0, s0 = {0.f, 0.f, 0.f, 0.f}, s1 = s0;
                    if (ropew) { c0 = *(const f32x4*)(rope + pos * 8); c1 = *(const f32x4*)(rope + pos * 8 + 4); s0 = *(const f32x4*)(rope + 32768 + pos * 8); s1 = *(const f32x4*)(rope + 32768 + pos * 8 + 4); }
#pragma unroll
                    for (int bj = 0; bj < 2; ++bj) { f32x4 v0 = acc[ai][bj][m][0], v1 = acc[ai][bj][m][1];
                        if (ropew) { f32x4 o0, o1;
#pragma unroll
                            for (int i = 0; i < 4; ++i) { o0[i] = get_xor16(v0[i], (fq & 1) != 0); o1[i] = get_xor16(v1[i], (fq & 1) != 0); }
                            if (fq == 0) { v0 = v0 * c0 - o0 * s0; v1 = v1 * c1 - o1 * s1; } else if (fq == 1) { v0 = v0 * c0 + o0 * s0; v1 = v1 * c1 + o1 * s1; } }
                        v0 = v0 * (sc * rstd); v1 = v1 * (sc * rstd);
                        *(u32x4*)(base + (size_t)row * 1024 + colt + bj * HALF + cw) = pack8(v0, v1); }
                    asm volatile("" ::: "memory"); }
        } else if (pn < 14) {
#pragma unroll
            for (int ai = 0; ai < 2; ++ai)
#pragma unroll
                for (int m = 0; m < 4; ++m) { const int row = row0 + ai * HALF + m * 16; const float rstd = rstd_of(SS[row]);
#pragma unroll
                    for (int bj = 0; bj < 2; ++bj) { const int cc = (pn - 12) * BM + bj * HALF + cw, g = cc >> 4, h0 = cc & 15;
                        *(u32x4*)(US + ((size_t)g * NTOK + row) * 16 + h0) = pack8(acc[ai][bj][m][0] * rstd, acc[ai][bj][m][1] * rstd); } }
        } else {
#pragma unroll
            for (int ai = 0; ai < 2; ++ai)
#pragma unroll
                for (int m = 0; m < 4; ++m) { const int row = row0 + ai * HALF + m * 16; const float rstd = rstd_of(SS[row]);
#pragma unroll
                    for (int bj = 0; bj < 2; ++bj) { const int cc = (pn - 14) * BM + bj * HALF + cw;
                        *(u32x4*)(UP + (size_t)row * 512 + cc) = pack8(acc[ai][bj][m][0] * rstd, acc[ai][bj][m][1] * rstd); } }
        }
    }
};
struct EpiSsm1 { static constexpr bool PERM = true, AFTER_DRAIN = false; static constexpr bool PERM2 = false; static constexpr int NVM = 16;
    bf16_t* YI; size_t zoff;
    __device__ __forceinline__ void operator()(const f32x4 (&acc)[2][2][4][2], const Unit& u, int wr, int wc, int fr, int fq) const {
        asm volatile("" : "+v"(fr), "+v"(fq));
        const int row0 = u.pm * BM + wr * 64 + fr, col0 = wc * 32 + 8 * fq; bf16_t* O = YI + (size_t)(u.pn & 1) * zoff;
#pragma unroll
        for (int ai = 0; ai < 2; ++ai)
#pragma unroll
            for (int m = 0; m < 4; ++m) { bf16_t* rp = O + (size_t)(row0 + ai * HALF + m * 16) * 256 + col0;
#pragma unroll
                for (int bj = 0; bj < 2; ++bj) *(u32x4*)(rp + bj * HALF) = pack8(acc[ai][bj][m][0], acc[ai][bj][m][1]); }
    }
};
__device__ __forceinline__ float gelu_tanh(float y) {
    const float u2 = 1.5957691216057308f * (y + 0.044715f * y * y * y);
    return y * __builtin_amdgcn_rcpf(1.f + __builtin_amdgcn_exp2f(-1.4426950408889634f * u2));
}
struct EpiSsm2 { static constexpr bool PERM = true, AFTER_DRAIN = false; static constexpr bool PERM2 = false; static constexpr int NVM = 32;
    const bf16_t* YI; bf16_t* ZB;
    __device__ __forceinline__ void operator()(const f32x4 (&acc)[2][2][4][2], const Unit& u, int wr, int wc, int fr, int fq) const {
        asm volatile("" : "+v"(fr), "+v"(fq));
        const int g = u.pn, row0 = u.pm * BM + wr * 64 + fr, col0 = wc * 32 + 8 * fq;
#pragma unroll
        for (int ai = 0; ai < 2; ++ai)
#pragma unroll
            for (int m = 0; m < 4; ++m) { const int row = row0 + ai * HALF + m * 16, chunk = row - g * NCHUNK;
#pragma unroll
                for (int bj = 0; bj < 2; ++bj) { const int col = col0 + bj * HALF; const u32x4 yi = *(const u32x4*)(YI + (size_t)row * 256 + col); const f32x4 a = acc[ai][bj][m][0], b = acc[ai][bj][m][1];
                    const f32x4 v = {gelu_tanh(a[0] + bf_lo(yi.x)), gelu_tanh(a[1] + bf_hi(yi.x)), gelu_tanh(a[2] + bf_lo(yi.y)), gelu_tanh(a[3] + bf_hi(yi.y))};
                    const f32x4 w = {gelu_tanh(b[0] + bf_lo(yi.z)), gelu_tanh(b[1] + bf_hi(yi.z)), gelu_tanh(b[2] + bf_lo(yi.w)), gelu_tanh(b[3] + bf_hi(yi.w))};
                    *(u32x4*)(ZB + (size_t)(chunk * CH_T + (col >> 4)) * 512 + g * 16 + (col & 15)) = pack8(v, w); }
                asm volatile("" ::: "memory"); }
    }
};
struct EpiGluPool { static constexpr bool PERM = true, AFTER_DRAIN = false; static constexpr bool PERM2 = false; static constexpr int NVM = 16;
    const bf16_t* ZB; const float* glu_b; bf16_t* MIX;
    __device__ __forceinline__ void operator()(const f32x4 (&acc)[2][2][4][2], const Unit& u, int wr, int wc, int fr, int fq) const {
        asm volatile("" : "+v"(fr), "+v"(fq));
        const bool glu = u.pn < 2; const int pm = glu ? u.pm : u.pm - 192, pn = glu ? u.pn : u.pn - 2;
        const int row0 = pm * BM + wr * 64 + fr, col0 = pn * BM + wc * 32 + 8 * fq;
#pragma unroll
        for (int ai = 0; ai < 2; ++ai)
#pragma unroll
            for (int m = 0; m < 4; ++m) { const int row = row0 + ai * HALF + m * 16;
#pragma unroll
                for (int bj = 0; bj < 2; ++bj) { const int col = col0 + bj * HALF; f32x4 v0 = acc[ai][bj][m][0], v1 = acc[ai][bj][m][1];
                    if (glu) { const u32x4 zz = *(const u32x4*)(ZB + (size_t)row * 512 + col); const f32x4 b0 = *(const f32x4*)(glu_b + col), b1 = *(const f32x4*)(glu_b + col + 4);
                        const float z[8] = {bf_lo(zz.x), bf_hi(zz.x), bf_lo(zz.y), bf_hi(zz.y), bf_lo(zz.z), bf_hi(zz.z), bf_lo(zz.w), bf_hi(zz.w)};
#pragma unroll
                        for (int i = 0; i < 4; ++i) { v0[i] = z[i] * __builtin_amdgcn_rcpf(1.f + __builtin_amdgcn_exp2f(-1.4426950408889634f * (v0[i] + b0[i])));
                                                      v1[i] = z[4 + i] * __builtin_amdgcn_rcpf(1.f + __builtin_amdgcn_exp2f(-1.4426950408889634f * (v1[i] + b1[i]))); } }
                    *(u32x4*)(MIX + (size_t)row * DM + (glu ? 1024 : 1536) + col) = pack8(v0, v1); } }
    }
};
struct EpiResidX { static constexpr bool PERM = true, AFTER_DRAIN = false; static constexpr bool PERM2 = false; static constexpr int NVM = 32;
    const bf16_t* XI; bf16_t* XO; unsigned long long* SS; int row_off;
    __device__ __forceinline__ void operator()(const f32x4 (&acc)[2][2][4][2], const Unit& u, int wr, int wc, int fr, int fq) const {
        asm volatile("" : "+v"(fr), "+v"(fq));
        const int row0 = u.pm * BM + wr * 64 + fr + row_off, col0 = u.pn * BM + wc * 32 + 8 * fq;
#pragma unroll
        for (int ai = 0; ai < 2; ++ai) {
            u32x4 bv[4][2];
#pragma unroll
            for (int m = 0; m < 4; ++m) { const bf16_t* bp = XI + (size_t)(row0 + ai * HALF + m * 16) * DM + col0;
#pragma unroll
                for (int bj = 0; bj < 2; ++bj) bv[m][bj] = *(const u32x4*)(bp + bj * HALF); }
#pragma unroll
            for (int m = 0; m < 4; ++m) { const int row = row0 + ai * HALF + m * 16; bf16_t* xp = XO + (size_t)row * DM + col0;
                float s = 0.f;
#pragma unroll
                for (int bj = 0; bj < 2; ++bj) { const u32x4 x = bv[m][bj]; const f32x4 a = acc[ai][bj][m][0], b = acc[ai][bj][m][1];
                    const f32x4 v = {bf_lo(x.x) + a[0], bf_hi(x.x) + a[1], bf_lo(x.y) + a[2], bf_hi(x.y) + a[3]}, w = {bf_lo(x.z) + b[0], bf_hi(x.z) + b[1], bf_lo(x.w) + b[2], bf_hi(x.w) + b[3]};
                    s += ((v[0] * v[0] + v[1] * v[1]) + (v[2] * v[2] + v[3] * v[3])) + ((w[0] * w[0] + w[1] * w[1]) + (w[2] * w[2] + w[3] * w[3]));
                    *(u32x4*)(xp + bj * HALF) = pack8(v, w); }
                s = sum_xor32(sum_xor16(s));
                if (fq == 0) __hip_atomic_fetch_add(SS + row, (unsigned long long)(s * 1048576.f + 0.5f), __ATOMIC_RELAXED, __HIP_MEMORY_SCOPE_AGENT); }
            asm volatile("" ::: "memory");
        }
    }
};
struct EpiSqRelu { static constexpr bool PERM = true, AFTER_DRAIN = false; static constexpr bool PERM2 = true; static constexpr int NVM = 16;
    bf16_t* HID; int row_off; const unsigned long long* SS;
    __device__ __forceinline__ void operator()(const f32x4 (&acc)[2][2][4][2], const Unit& u, int wr, int wc, int fr, int fq) const {
        asm volatile("" : "+v"(fr), "+v"(fq));
        const int rown = u.pm * BM + wr * 64 + fr;
        bf16_t* base = HID + (size_t)(u.pm * BM + wr * 64 + (fr & 7) - row_off) * DFF + u.pn * BM + wc * 64 + 32 * (fr >> 3) + 8 * fq;
#pragma unroll
        for (int ai = 0; ai < 2; ++ai)
#pragma unroll
            for (int m = 0; m < 4; ++m) { const float rstd = rstd_of(SS[rown + ai * HALF + m * 16]);
                u32x4 d[2];
#pragma unroll
                for (int bj = 0; bj < 2; ++bj) { f32x4 v0 = acc[ai][bj][m][0], v1 = acc[ai][bj][m][1];
#pragma unroll
                    for (int i = 0; i < 4; ++i) { const float a = fmaxf(v0[i], 0.f) * rstd, b = fmaxf(v1[i], 0.f) * rstd; v0[i] = a * a; v1[i] = b * b; }
                    d[bj] = pack8(v0, v1); }
                u32x4 x, y;
#pragma unroll
                for (int i = 0; i < 4; ++i) { x[i] = (unsigned)__builtin_amdgcn_update_dpp((int)d[0][i], (int)d[1][i], 0x128, 0xF, 0xC, false);
                                              y[i] = (unsigned)__builtin_amdgcn_update_dpp((int)d[1][i], (int)d[0][i], 0x128, 0xF, 0x3, false); }
                bf16_t* p = base + (size_t)(ai * HALF + m * 16) * DFF;
                *(u32x4*)p = x; *(u32x4*)(p + (size_t)8 * DFF) = y; }
    }
};

#ifdef PROBE_EPI2
template <class E> struct Probe2 { static constexpr bool v = false; };
#if PROBE_EPI2 == 1
template <> struct Probe2<EpiInProj> { static constexpr bool v = true; };
template <> struct Probe2<EpiVT> { static constexpr bool v = true; };
#else
template <> struct Probe2<EpiSqRelu> { static constexpr bool v = true; };
#endif
#endif
template <class Epi, class Sched, bool ALIGN_EPI = false, bool SP2 = false>
__device__ __forceinline__ void gemm_phase(PG8_LAS unsigned char* lds, const Gemm g, const Sched& S, const Epi& E, int tid_) {
    asm volatile("" : "+v"(tid_));
    const int tid = tid_, wid = __builtin_amdgcn_readfirstlane(tid >> 6), lane = tid & 63, wr = wid >> 2, wc = wid & 3, fr = lane & 15, fq = lane >> 4;
    const int K = g.K, nt = K / BK;
    unsigned voffA[2], voffB[2];
#pragma unroll
    for (int i = 0; i < 2; ++i) { int R, C; stage_rc(tid * 16 + i * 8192, R, C); const int Rb = Epi::PERM2 ? ((R >> 5) * 64 + perm32(R & 31)) : Epi::PERM ? ((R & ~31) + perm32(R & 31)) : R;
        voffA[i] = (unsigned)(R * K + C) * 2u; voffB[i] = (unsigned)(Rb * K + C) * 2u; }
    const size_t kstep = (size_t)(BK * 2);
    const size_t hstep = (size_t)HALF * K * 2;
    const size_t hstepB = Epi::PERM2 ? (size_t)32 * K * 2 : hstep;
    const size_t tstep = 2 * hstep;
    const unsigned ldsw = (unsigned)wid * 1024u;
    const int aoff = lds_byte(wr * 64 + fr, fq * 8), boff = lds_byte(wc * 32 + fr, fq * 8);
#define PG8_SA(b, h) (((b) * 2 + (h)) * HTB)
#define PG8_SB(b, h) ((4 + (b) * 2 + (h)) * HTB)
    const unsigned lds_u32 = (unsigned)(uintptr_t)lds + ldsw;
#define PG8_STAGE(bufoff, gbase, voff) do { _Pragma("unroll") for (int _i = 0; _i < 2; ++_i) \
        glds_saddr((const char*)(gbase), (voff)[_i], lds_u32 + (unsigned)((bufoff) + _i * 8192)); } while (0)
#define PG8_LDA(dst, b, h) do { _Pragma("unroll") for (int m = 0; m < 4; ++m) _Pragma("unroll") for (int k = 0; k < 2; ++k) dst[m][k] = *(const PG8_LAS bf16x8*)(lds + PG8_SA(b, h) + aoff + m * 2048 + k * 1024); } while (0)
#define PG8_LDB(dst, b, h) do { _Pragma("unroll") for (int n = 0; n < 2; ++n) _Pragma("unroll") for (int k = 0; k < 2; ++k) dst[n][k] = *(const PG8_LAS bf16x8*)(lds + PG8_SB(b, h) + boff + n * 2048 + k * 1024); } while (0)
#define PG8_MMA(ai, bj, At, Bt) do { __builtin_amdgcn_s_setprio(1); _Pragma("unroll") for (int m = 0; m < 4; ++m) _Pragma("unroll") for (int n = 0; n < 2; ++n) _Pragma("unroll") for (int k = 0; k < 2; ++k) \
        acc[ai][bj][m][n] = __builtin_amdgcn_mfma_f32_16x16x32_bf16(Bt[n][k], At[m][k], acc[ai][bj][m][n], 0, 0, 0); __builtin_amdgcn_s_setprio(0); } while (0)
#define PG8_WAIT_V(n) asm volatile("s_waitcnt vmcnt(" #n ")" ::: "memory")
#define PG8_WAIT_L(n) asm volatile("s_waitcnt lgkmcnt(" #n ")" ::: "memory")
#define PG8_WAIT_VR(rx) do { if (rx) asm volatile("s_waitcnt vmcnt(%0)" :: "n"(8 + Epi::NVM) : "memory"); else PG8_WAIT_V(8); } while (0)
#define PG8_BAR __builtin_amdgcn_s_barrier()
#define PG8_SCHED __builtin_amdgcn_sched_barrier(0)
    Unit cur, nxt; int ui = 0;
    if (!S.next(0, cur)) return;
    f32x4 acc[2][2][4][2];
#pragma unroll
    for (int a = 0; a < 2; ++a)
#pragma unroll
        for (int b = 0; b < 2; ++b)
#pragma unroll
            for (int m = 0; m < 4; ++m)
#pragma unroll
                for (int n = 0; n < 2; ++n) acc[a][b][m][n] = (f32x4){0.f, 0.f, 0.f, 0.f};
    bf16x8 At[4][2], B0[2][2], B1[2][2];
    const char* cA = (const char*)g.A + (size_t)cur.pm * tstep; const char* cB = (const char*)g.Bt + (size_t)cur.pn * tstep;
    S.a_ready(cur);
    if constexpr (SP2) {
        PG8_STAGE(PG8_SB(0, 0), cB, voffB); PG8_STAGE(PG8_SB(0, 1), cB + hstepB, voffB); PG8_STAGE(PG8_SA(0, 0), cA, voffA); PG8_STAGE(PG8_SA(0, 1), cA + hstep, voffA);
        if (wr == 1) PG8_BAR;
        PG8_WAIT_V(2); PG8_BAR;
        PG8_STAGE(PG8_SB(1, 0), cB + kstep, voffB); PG8_STAGE(PG8_SA(1, 0), cA + kstep, voffA); PG8_STAGE(PG8_SB(1, 1), cB + hstepB + kstep, voffB);
        PG8_WAIT_V(0); PG8_BAR;
    } else {
        PG8_STAGE(PG8_SB(0, 0), cB, voffB); PG8_STAGE(PG8_SA(0, 0), cA, voffA); PG8_STAGE(PG8_SB(0, 1), cB + hstepB, voffB); PG8_STAGE(PG8_SA(0, 1), cA + hstep, voffA);
        if (wr == 1) PG8_BAR;
        PG8_WAIT_V(4); PG8_BAR;
        PG8_STAGE(PG8_SB(1, 0), cB + kstep, voffB); PG8_STAGE(PG8_SA(1, 0), cA + kstep, voffA); PG8_STAGE(PG8_SB(1, 1), cB + hstepB + kstep, voffB);
        PG8_WAIT_V(6); PG8_BAR;
    }
    for (;;) {
        const bool has_next = S.next(ui + 1, nxt);
        const char* nA = has_next ? (const char*)g.A + (size_t)nxt.pm * tstep : cA; const char* nB = has_next ? (const char*)g.Bt + (size_t)nxt.pn * tstep : cB;
        for (int t = 0; t < nt; t += 2) {
            const bool last = (t == nt - 2);
            const bool relax = SP2 && (t == 0);
            const char* a1 = cA + (size_t)(t + 1) * kstep;
            const char* a2 = last ? nA : cA + (size_t)(t + 2) * kstep; const char* b2 = last ? nB : cB + (size_t)(t + 2) * kstep;
            const char* a3 = a2 + kstep; const char* b3 = b2 + kstep;
            if (last && has_next) S.a_ready(nxt);
            if constexpr (SP2) {
            PG8_LDB(B0, 0, 0); PG8_LDB(B1, 0, 1); PG8_SCHED; PG8_LDA(At, 0, 0); PG8_STAGE(PG8_SA(1, 1), a1 + hstep, voffA);
            PG8_WAIT_VR(relax); PG8_WAIT_L(0); PG8_BAR; PG8_MMA(0, 0, At, B0); PG8_MMA(0, 1, At, B1); PG8_BAR; PG8_SCHED;
            PG8_LDA(At, 0, 1); PG8_STAGE(PG8_SB(0, 0), b2, voffB); PG8_STAGE(PG8_SB(0, 1), b2 + hstepB, voffB); PG8_STAGE(PG8_SA(0, 0), a2, voffA);
            PG8_WAIT_VR(relax); PG8_WAIT_L(0); PG8_BAR; PG8_MMA(1, 0, At, B0); PG8_MMA(1, 1, At, B1); PG8_BAR; PG8_SCHED;
            PG8_LDB(B0, 1, 0); PG8_LDB(B1, 1, 1); PG8_SCHED; PG8_LDA(At, 1, 0); PG8_STAGE(PG8_SA(0, 1), a2 + hstep, voffA);
            PG8_WAIT_V(8); PG8_WAIT_L(0); PG8_BAR; PG8_MMA(0, 0, At, B0); PG8_MMA(0, 1, At, B1); PG8_BAR; PG8_SCHED;
            PG8_LDA(At, 1, 1); PG8_STAGE(PG8_SB(1, 0), b3, voffB); PG8_STAGE(PG8_SB(1, 1), b3 + hstepB, voffB); PG8_STAGE(PG8_SA(1, 0), a3, voffA);
            PG8_WAIT_V(8); PG8_WAIT_L(0); PG8_BAR; PG8_MMA(1, 0, At, B0); PG8_MMA(1, 1, At, B1); PG8_BAR; PG8_SCHED;
            } else {
            PG8_LDB(B0, 0, 0); PG8_SCHED; PG8_LDA(At, 0, 0); PG8_STAGE(PG8_SA(1, 1), a1 + hstep, voffA);
            PG8_WAIT_L(8); PG8_BAR; PG8_WAIT_L(0); PG8_MMA(0, 0, At, B0); PG8_BAR; PG8_SCHED;
            PG8_LDB(B1, 0, 1); PG8_STAGE(PG8_SB(0, 0), b2, voffB);
            PG8_BAR; PG8_WAIT_L(0); PG8_MMA(0, 1, At, B1); PG8_BAR;
            PG8_LDA(At, 0, 1); PG8_STAGE(PG8_SA(0, 0), a2, voffA);
            PG8_BAR; PG8_WAIT_L(0); PG8_MMA(1, 0, At, B0); PG8_BAR; PG8_SCHED;
            PG8_STAGE(PG8_SB(0, 1), b2 + hstepB, voffB);
            PG8_WAIT_V(6); PG8_BAR; PG8_MMA(1, 1, At, B1); PG8_BAR;
            PG8_LDB(B0, 1, 0); PG8_SCHED; PG8_LDA(At, 1, 0); PG8_STAGE(PG8_SA(0, 1), a2 + hstep, voffA);
            PG8_WAIT_L(8); PG8_BAR; PG8_WAIT_L(0); PG8_MMA(0, 0, At, B0); PG8_BAR; PG8_SCHED;
            PG8_LDB(B1, 1, 1); PG8_STAGE(PG8_SB(1, 0), b3, voffB);
            PG8_BAR; PG8_WAIT_L(0); PG8_MMA(0, 1, At, B1); PG8_BAR;
            PG8_LDA(At, 1, 1); PG8_STAGE(PG8_SA(1, 0), a3, voffA);
            PG8_BAR; PG8_WAIT_L(0); PG8_MMA(1, 0, At, B0); PG8_BAR; PG8_SCHED;
            PG8_STAGE(PG8_SB(1, 1), b3 + hstepB, voffB);
            PG8_WAIT_V(6); PG8_BAR; PG8_MMA(1, 1, At, B1); PG8_BAR;
            }
        }
        if constexpr (ALIGN_EPI) { if (wr == 0) PG8_BAR; }
        if constexpr (!Epi::AFTER_DRAIN) { E(acc, cur, wr, wc, fr, fq);
#ifdef PROBE_EPI2
            if constexpr (Probe2<Epi>::v) { asm volatile("" ::: "memory"); E(acc, cur, wr, wc, fr, fq); }
#endif
            S.done(cur); }
        if (!has_next) break;
#pragma unroll
        for (int a = 0; a < 2; ++a)
#pragma unroll
            for (int b = 0; b < 2; ++b)
#pragma unroll
                for (int m = 0; m < 4; ++m)
#pragma unroll
                    for (int n = 0; n < 2; ++n) acc[a][b][m][n] = (f32x4){0.f, 0.f, 0.f, 0.f};
        cur = nxt; cA = nA; cB = nB; ++ui;
        if constexpr (ALIGN_EPI) { if (wr == 1) PG8_BAR; }
    }
    PG8_WAIT_V(0);
    if constexpr (!ALIGN_EPI) { if (wr == 0) PG8_BAR; }
    PG8_BAR;
    if constexpr (Epi::AFTER_DRAIN) { E.fused(acc, cur, wr, wc, fr, fq, lds, wid, lane); S.done(cur); }
#undef PG8_SA
#undef PG8_SB
#undef PG8_STAGE
#undef PG8_LDA
#undef PG8_LDB
#undef PG8_MMA
#undef PG8_WAIT_V
#undef PG8_WAIT_L
#undef PG8_WAIT_VR
#undef PG8_BAR
#undef PG8_SCHED
}
}
constexpr int NWAVES = 8;
constexpr size_t MiB = 1u << 20;
constexpr size_t WS_CTL = 0, CTL_ZERO_BYTES = 1 * MiB;
constexpr size_t WS_SS = 4 * MiB, SS_BYTES = 4 * MiB;
constexpr size_t WS_ROPE = 1 * MiB;
constexpr size_t WS_AT = 2 * MiB;
constexpr size_t WS_WIN = 16 * MiB, WS_WOUT = 32 * MiB, WS_WUP = 40 * MiB, WS_WDN = 72 * MiB;
constexpr size_t WS_SSM1 = 104 * MiB, WS_SSM2 = 112 * MiB, WS_GP = 116 * MiB;
constexpr size_t WS_HB = 120 * MiB;
constexpr size_t WS_Q = 312 * MiB, WS_K = 408 * MiB, WS_VT = 504 * MiB, WS_US = 600 * MiB, WS_UP = 648 * MiB;
constexpr size_t WS_YI = 696 * MiB, WS_Z = 744 * MiB, WS_SP = 840 * MiB, WS_ZB = 888 * MiB, WS_PL = 936 * MiB;
constexpr size_t WS_HID = 312 * MiB;
constexpr size_t WS_END = 984 * MiB;
static_assert(WS_PL == WS_ZB + (size_t)NTOK * 512 * 2 && WS_HID + (size_t)8192 * DFF * 2 <= WS_YI, "ws map");
constexpr int CW_BAR = 4096;
constexpr int RING_BYTES = 131072, LDSCTL_OFF = RING_BYTES, MISC_OFF = LDSCTL_OFF + 320, LDS_BYTES = 147456;

#define GAS __attribute__((address_space(1)))
#define LAS __attribute__((address_space(3)))
typedef unsigned short bf16;
typedef unsigned v4u __attribute__((ext_vector_type(4)));
typedef unsigned v2u __attribute__((ext_vector_type(2)));
typedef float f32x4 __attribute__((ext_vector_type(4)));
typedef float f32x16 __attribute__((ext_vector_type(16)));
typedef short bf16x8 __attribute__((ext_vector_type(8)));
typedef GAS unsigned gu32;
#define LDS_WAIT() asm volatile("s_waitcnt lgkmcnt(0)" ::: "memory")
#define VM_WAIT() asm volatile("s_waitcnt vmcnt(0)" ::: "memory")
using pg8::cvt_pk_bf16; using pg8::bf_lo; using pg8::bf_hi;

#define XB_TMO      128
#define XB_XCNT(j)  (256  + 64 * (j))
#define XB_XSUB(j)  (1280 + 64 * (j))
#define XB_XGEN(j)  (2304 + 64 * (j))
#define XB_TOP      3328
#define XB_TOPGEN   3392
#define XCD_BAR_WORDS 3456
#define XB_SPIN_CAP (1u << 18)

__device__ __forceinline__ unsigned xb_ld(unsigned* p)              { return __hip_atomic_load(p, __ATOMIC_RELAXED, __HIP_MEMORY_SCOPE_AGENT); }
__device__ __forceinline__ unsigned xb_add(unsigned* p, unsigned v) { return __hip_atomic_fetch_add(p, v, __ATOMIC_RELAXED, __HIP_MEMORY_SCOPE_AGENT); }
__device__ __forceinline__ unsigned xb_xcc_id() { return (unsigned)__builtin_amdgcn_s_getreg((3 << 11) | 20) & 0xFu; }
#define XB_SPIN(cond, bar) do { unsigned _sp = 0; while (cond) { __builtin_amdgcn_s_sleep(1); \
    if ((++_sp & 255u) == 0u) { if (xb_ld(&(bar)[XB_TMO])) break; if (_sp > XB_SPIN_CAP) { atomicAdd(&(bar)[XB_TMO], 1u); break; } } } } while (0)

struct XcdBarrier {
    unsigned* bar; unsigned x;
    volatile LAS unsigned* st;
};

__device__ __forceinline__ XcdBarrier xcd_barrier_post(unsigned* bar, volatile LAS unsigned* st) {
    XcdBarrier b; b.bar = bar; b.x = xb_xcc_id(); b.st = st;
    if (threadIdx.x == 0) (void)xb_add(&bar[XB_XCNT(b.x)], 1u);
    return b;
}
__device__ __forceinline__ void xcd_barrier_complete(unsigned* bar, unsigned x, unsigned& nloc, unsigned& nx) {
    const unsigned G = gridDim.x * gridDim.y * gridDim.z;
    unsigned sum, cnt, mine, sp = 0u;
    for (;;) {
        sum = 0u; cnt = 0u; mine = 0u;
#pragma unroll
        for (unsigned j = 0; j < 16; ++j) { const unsigned c = xb_ld(&bar[XB_XCNT(j)]); sum += c; cnt += (c > 0u) ? 1u : 0u; mine = (j == x) ? c : mine; }
        if (sum == G) break;
        __builtin_amdgcn_s_sleep(1);
        if ((++sp & 255u) == 0u) { if (xb_ld(&bar[XB_TMO])) break; if (sp > XB_SPIN_CAP) { atomicAdd(&bar[XB_TMO], 1u); break; } }
    }
    nloc = mine > 0u ? mine : 1u; nx = cnt > 0u ? cnt : 1u;
}

__device__ __forceinline__ void xcd_barrier(const XcdBarrier& b) {
    asm volatile("s_waitcnt vmcnt(0)" ::: "memory");
    __syncthreads();
    if (threadIdx.x == 0) {
        unsigned* bar = b.bar;
        __builtin_amdgcn_s_waitcnt(0);
        unsigned nloc = b.st[0], nx = b.st[1];
        if (nloc == 0u) { xcd_barrier_complete(bar, b.x, nloc, nx); b.st[0] = nloc; b.st[1] = nx; }
        const unsigned old = xb_add(&bar[XB_XSUB(b.x)], 1u);
        const unsigned gen = old / nloc;
        if (old + 1u == (gen + 1u) * nloc) {
            __builtin_amdgcn_fence(__ATOMIC_RELEASE, "agent");
            asm volatile("s_waitcnt vmcnt(0)" ::: "memory");
            const unsigned og = xb_add(&bar[XB_TOP], 1u);
            const unsigned tg = og / nx;
            if (og + 1u == (tg + 1u) * nx) xb_add(&bar[XB_TOPGEN], 1u);
            else XB_SPIN(xb_ld(&bar[XB_TOPGEN]) == tg, bar);
            __builtin_amdgcn_fence(__ATOMIC_ACQUIRE, "agent");
            xb_add(&bar[XB_XGEN(b.x)], 1u);
            asm volatile("s_waitcnt vmcnt(0)" ::: "memory");
        } else {
            XB_SPIN(xb_ld(&bar[XB_XGEN(b.x)]) == gen, bar);
            __builtin_amdgcn_fence(__ATOMIC_ACQUIRE, "agent");
            asm volatile("s_waitcnt vmcnt(0)" ::: "memory");
        }
    }
    __syncthreads();
}
struct Frame {
    LAS unsigned char* lds;
    int tid, lane, wave, vcu, G;
    float* out; unsigned char* ws;
};
__device__ __forceinline__ float wave_sum(float v, int lane) {
#pragma unroll
    for (int o = 1; o < 16; o <<= 1) v += __uint_as_float((unsigned)__builtin_amdgcn_ds_bpermute((lane ^ o) << 2, (int)__float_as_uint(v)));
    return pg8::sum_xor32(pg8::sum_xor16(v));
}
__device__ __forceinline__ void transpose_item(const float* W, int K, int N, bf16* WT, LAS float* scr, int item, int lane, const float* gain = nullptr) {
    const int nblk = N / 32, kb = item / nblk, nb = item % nblk, k0 = 64 * kb, n0 = 32 * nb;
#pragma unroll 8
    for (int i = 0; i < 32; ++i) { const int kk = 2 * i + (lane >> 5); scr[kk * 33 + (lane & 31)] = W[(size_t)(k0 + kk) * N + n0 + (lane & 31)] * (gain ? gain[k0 + kk] : 1.f); }
    LDS_WAIT(); asm volatile("" ::: "memory");
    const int c = lane & 7;
#pragma unroll
    for (int j = 0; j < 4; ++j) { const int n = (lane >> 3) + 8 * j; const LAS float* s = scr + (8 * c) * 33 + n;
        v4u o; o.x = cvt_pk_bf16(s[0 * 33], s[1 * 33]); o.y = cvt_pk_bf16(s[2 * 33], s[3 * 33]); o.z = cvt_pk_bf16(s[4 * 33], s[5 * 33]); o.w = cvt_pk_bf16(s[6 * 33], s[7 * 33]);
        *(v4u*)(WT + (size_t)(n0 + n) * K + k0 + 8 * c) = o; }
    LDS_WAIT(); asm volatile("" ::: "memory");
}
struct WPtrs { const float *w_in, *w_out, *glu_w, *pool_w, *pool_s, *w_up, *w_dn, *g_mix, *g_mlp; };
__device__ __forceinline__ void convert_weights(Frame& F, const WPtrs& W, int l, int what, int cu_idx, int cu_cnt) {
    LAS float* scr = (LAS float*)(F.lds + F.wave * 16384);
    const int gw = cu_idx * NWAVES + F.wave, NGW = cu_cnt * NWAVES;
    bf16* Win_t = (bf16*)(F.ws + WS_WIN); bf16* Wout_t = (bf16*)(F.ws + WS_WOUT); bf16* Wup_t = (bf16*)(F.ws + WS_WUP); bf16* Wdn_t = (bf16*)(F.ws + WS_WDN); bf16* GP = (bf16*)(F.ws + WS_GP);
    if (what & 1) {
        const float* w_in = W.w_in + (size_t)l * DM * 4096; const float* w_out = W.w_out + (size_t)l * DM * DM; const float* glu_w = W.glu_w + (size_t)l * 512 * 512;
        constexpr int I_IN = (DM / 64) * (4096 / 32), I_OUT = (DM / 64) * (DM / 32), I_GLU = (512 / 64) * (512 / 32);
        for (int it = gw; it < I_IN + I_OUT + I_GLU; it += NGW) {
            int r = it;
            if (r < I_IN) { transpose_item(w_in, DM, 4096, Win_t, scr, r, F.lane, W.g_mix + (size_t)l * DM); continue; } r -= I_IN;
            if (r < I_OUT) { transpose_item(w_out, DM, DM, Wout_t, scr, r, F.lane); continue; } r -= I_OUT;
            transpose_item(glu_w, 512, 512, GP, scr, r, F.lane);
        }
        const float* pool_w = W.pool_w + (size_t)l * 4 * 128 * 128; const float* pool_s = W.pool_s + (size_t)l * 512;
        for (int e = (cu_idx * 512 + F.tid); e < 512 * 512; e += cu_cnt * 512) { const int n = e >> 9, k = e & 511, gi = n >> 7, gj = k >> 7;
            const float v = (gi == gj) ? pool_w[((size_t)gi * 128 + (k & 127)) * 128 + (n & 127)] * pool_s[n] : 0.f;
            GP[(size_t)(512 + n) * 512 + k] = (bf16)(cvt_pk_bf16(v, 0.f) & 0xffffu); }
    }
    if (what & 2) {
        const float* w_up = W.w_up + (size_t)l * DM * DFF; const float* w_dn = W.w_dn + (size_t)l * DFF * DM;
        constexpr int I_UP = (DM / 64) * (DFF / 32), I_DN = (DFF / 64) * (DM / 32);
        for (int it = gw; it < I_UP + I_DN; it += NGW) {
            if (it < I_UP) transpose_item(w_up, DM, DFF, Wup_t, scr, it, F.lane, W.g_mlp + (size_t)l * DM); else transpose_item(w_dn, DFF, DM, Wdn_t, scr, it - I_UP, F.lane);
        }
    }
    if (what & 4) {
        float* rope = (float*)(F.ws + WS_ROPE);
        for (int e = cu_idx * 512 + F.tid; e < 4096 * 8; e += cu_cnt * 512) { const int pos = e >> 3, j = e & 7;
            const float inv = powf(500000.0f, -(float)(2 * j) / 16.0f); const float ang = (float)pos * inv; float s, c; sincosf(ang, &s, &c);
            rope[e] = c; rope[32768 + e] = s; }
    }
}
struct SPtrs { const float *lam_re, *lam_im, *log_dt, *b_re, *b_im, *c_re, *c_im, *d; };
__device__ __forceinline__ void ssm_weights(Frame& F, const SPtrs& S, int l) {
    typedef float f2 __attribute__((ext_vector_type(2)));
    LAS f2* AP = (LAS f2*)F.lds;
    LAS f2* BB = AP + 2 * 64 * 17;
    LAS f2* CC = BB + 2 * 64 * 16;
    LAS float* KT = (LAS float*)(CC + 2 * 16 * 64);
    const float* lam_re = S.lam_re; const float* lam_im = S.lam_im; const float* log_dt = S.log_dt;
    const float* b_re = S.b_re; const float* b_im = S.b_im; const float* c_re = S.c_re; const float* c_im = S.c_im; const float* dskip = S.d + (size_t)l * 512;
    bf16* W1 = (bf16*)(F.ws + WS_SSM1); bf16* W2 = (bf16*)(F.ws + WS_SSM2); float* AT = (float*)(F.ws + WS_AT);
    for (int g = blockIdx.x; g < NGRP; g += F.G) {
        __syncthreads();
        if (F.tid < 128) { const int dir = F.tid >> 6, p = F.tid & 63; const int idx = (l * 2 + dir) * NGRP + g;
            const float lr = lam_re[(size_t)idx * 64 + p], li = lam_im[(size_t)idx * 64 + p], dt = expf(log_dt[idx]);
            for (int k = 0; k <= 16; ++k) { const float mag = expf(lr * dt * (float)k); float s, c; sincosf(li * dt * (float)k, &s, &c); AP[(dir * 64 + p) * 17 + k] = (f2){mag * c, mag * s}; }
            float s1, c1; sincosf(li * dt, &s1, &c1); const float mag1 = expf(lr * dt), ai = mag1 * s1; const float sh = sinf(0.5f * li * dt);
            const float nr = expm1f(lr * dt) * c1 - 2.f * sh * sh;
            const float den = lr * lr + li * li, cr = (nr * lr + ai * li) / den, ci = (ai * lr - nr * li) / den;
            for (int h = 0; h < 16; ++h) { const float br = b_re[((size_t)idx * 64 + p) * 16 + h], bi = b_im[((size_t)idx * 64 + p) * 16 + h]; BB[(dir * 64 + p) * 16 + h] = (f2){cr * br - ci * bi, cr * bi + ci * br}; }
            const f2 a16 = AP[(dir * 64 + p) * 17 + 16]; AT[((dir * NGRP + g) * 64 + p) * 2] = a16.x; AT[((dir * NGRP + g) * 64 + p) * 2 + 1] = a16.y;
        }
        for (int e = F.tid; e < 2 * 16 * 64; e += 512) { const int dir = e >> 10, h = (e >> 6) & 15, p = e & 63; const size_t gi = (((size_t)(l * 2 + dir) * NGRP + g) * 16 + h) * 64 + p; CC[e] = (f2){c_re[gi], c_im[gi]}; }
        __syncthreads();
        for (int e = F.tid; e < 8192; e += 512) { const int dir = e >> 12, k = (e >> 8) & 15, h = (e >> 4) & 15, hp = e & 15; float acc = 0.f;
            for (int p = 0; p < 64; ++p) { const f2 c = CC[(dir * 16 + h) * 64 + p], a = AP[(dir * 64 + p) * 17 + k], b = BB[(dir * 64 + p) * 16 + hp];
                const float wr = c.x * a.x - c.y * a.y, wi = c.x * a.y + c.y * a.x; acc += wr * b.x - wi * b.y; }
            KT[e] = acc; }
        __syncthreads();
        for (int e = F.tid; e < 512 * 256; e += 512) { const int n = e >> 8, kk = e & 255, j = kk >> 4, hp = kk & 15; float v;
            if (n < 256) { const int i = n >> 4, h = n & 15; v = 0.f;
                if (j <= i) v += KT[((0 * 16 + (i - j)) * 16 + h) * 16 + hp];
                if (j >= i) v += KT[((1 * 16 + (j - i)) * 16 + h) * 16 + hp];
                if (i == j && h == hp) v += dskip[g * 16 + h];
            } else { const int q = n - 256, dir = q >> 7, p = q & 63, im = (q >> 6) & 1, ex = dir == 0 ? 15 - j : j; const f2 a = AP[(dir * 64 + p) * 17 + ex], b = BB[(dir * 64 + p) * 16 + hp];
                v = im ? a.x * b.y + a.y * b.x : a.x * b.x - a.y * b.y; }
            W1[((size_t)g * 512 + n) * 256 + kk] = (bf16)(cvt_pk_bf16(v, 0.f) & 0xffffu); }
        for (int e = F.tid; e < 256 * 256; e += 512) { const int n = e >> 8, kk = e & 255, i = n >> 4, h = n & 15, dir = kk >> 7, p = kk & 63, im = (kk >> 6) & 1, ex = dir == 0 ? i + 1 : 16 - i;
            const f2 c = CC[(dir * 16 + h) * 64 + p], a = AP[(dir * 64 + p) * 17 + ex]; const float wr = c.x * a.x - c.y * a.y, wi = c.x * a.y + c.y * a.x;
            W2[((size_t)g * 256 + n) * 256 + kk] = (bf16)(cvt_pk_bf16(im ? -wi : wr, 0.f) & 0xffffu); }
    }
    __syncthreads();
}
__device__ __forceinline__ void input_rows(Frame& F, const float* x0, const float* x1, bf16* o, unsigned long long* SS) {
    const int gw = F.vcu * NWAVES + F.wave, NGW = F.G * NWAVES;
    for (int row = gw; row < NTOK; row += NGW) {
        const float* xr = row < NPROMPT ? x0 + (size_t)row * DM : x1 + (size_t)(row - NPROMPT) * DM;
        f32x4 v[8]; float s = 0.f;
#pragma unroll
        for (int j = 0; j < 8; ++j) { v[j] = ((const f32x4*)xr)[F.lane + 64 * j]; s += (v[j].x * v[j].x + v[j].y * v[j].y) + (v[j].z * v[j].z + v[j].w * v[j].w); }
        s = wave_sum(s, F.lane); if (F.lane == 0) SS[row] = (unsigned long long)(s * 1048576.f + 0.5f);
#pragma unroll
        for (int j = 0; j < 8; ++j) { v2u w; w.x = cvt_pk_bf16(v[j].x, v[j].y); w.y = cvt_pk_bf16(v[j].z, v[j].w); ((v2u*)(o + (size_t)row * DM))[F.lane + 64 * j] = w; }
    }
}
__device__ __forceinline__ void final_norm(Frame& F, const bf16* X, const float* g, const unsigned long long* SS) {
    const int gw = F.vcu * NWAVES + F.wave, NGW = F.G * NWAVES;
    for (int row = gw; row < NTOK; row += NGW) {
        const v2u* xr = (const v2u*)(X + (size_t)row * DM); f32x4* orow = (f32x4*)(F.out + (size_t)row * DM);
        const float rstd = pg8::rstd_of(SS[row]);
#pragma unroll
        for (int j = 0; j < 8; ++j) { const v2u x = xr[F.lane + 64 * j]; const f32x4 gg = ((const f32x4*)g)[F.lane + 64 * j];
            f32x4 o; o.x = bf_lo(x.x) * rstd * gg.x; o.y = bf_hi(x.x) * rstd * gg.y; o.z = bf_lo(x.y) * rstd * gg.z; o.w = bf_hi(x.y) * rstd * gg.w;
            orow[F.lane + 64 * j] = o; }
    }
}
__device__ __forceinline__ void pool_prepass(Frame& F) {
    const bf16* __restrict__ UP = (const bf16*)(F.ws + WS_UP); bf16* __restrict__ PL = (bf16*)(F.ws + WS_PL);
    const int ws_ = (F.G >= 256) ? 5 : 0, nw_ = NWAVES - ws_;
    if (F.wave < ws_) return;
    const int c8 = F.lane, gi = c8 >> 4, w = 2 << gi, lo = w >> 1, hi = (w >> 1) - 1;
#define POOL_ACC(sgn, V_) do { a[0] sgn bf_lo((V_).x); a[1] sgn bf_hi((V_).x); a[2] sgn bf_lo((V_).y); a[3] sgn bf_hi((V_).y); a[4] sgn bf_lo((V_).z); a[5] sgn bf_hi((V_).z); a[6] sgn bf_lo((V_).w); a[7] sgn bf_hi((V_).w); } while (0)
    for (int task = F.vcu * nw_ + (F.wave - ws_); task < NTOK / 32; task += F.G * nw_) {
        const int row0 = task * 32; const int L = row0 < NPROMPT ? 2048 : 4096, pos0 = row0 & (L - 1), seq0 = row0 - pos0;
        const bf16* col = UP + (size_t)seq0 * 512 + c8 * 8;
        float a[8] = {0.f, 0.f, 0.f, 0.f, 0.f, 0.f, 0.f, 0.f};
        { const int start = max(pos0 - lo, 0), end = min(pos0 + hi + 1, L);
          for (int k0 = 0; k0 < 32; k0 += 8) { v4u x[8];
#pragma unroll
              for (int j = 0; j < 8; ++j) { const int t = start + k0 + j; const bool ok = t < end; x[j] = *(const v4u*)(col + (size_t)(ok ? t : start) * 512); if (!ok) x[j] = (v4u){0u, 0u, 0u, 0u}; }
#pragma unroll
              for (int j = 0; j < 8; ++j) POOL_ACC(+=, x[j]); } }
        for (int r0 = 0; r0 < 32; r0 += 4) { v4u xe[4], xl[4], xs[4];
#pragma unroll
            for (int j = 0; j < 4; ++j) { const int pos = pos0 + r0 + j, ent = pos + hi, lev = pos - lo - 1; const bool ev = (r0 + j > 0) && ent < L, lv = (r0 + j > 0) && lev >= 0;
                xe[j] = *(const v4u*)(col + (size_t)(ev ? ent : pos) * 512); if (!ev) xe[j] = (v4u){0u, 0u, 0u, 0u};
                xl[j] = *(const v4u*)(col + (size_t)(lv ? lev : pos) * 512); if (!lv) xl[j] = (v4u){0u, 0u, 0u, 0u};
                xs[j] = *(const v4u*)(col + (size_t)pos * 512); }
#pragma unroll
            for (int j = 0; j < 4; ++j) { const int pos = pos0 + r0 + j; POOL_ACC(+=, xe[j]); POOL_ACC(-=, xl[j]);
                const float rc = 1.f / (float)(min(pos + hi + 1, L) - max(pos - lo, 0)); const v4u x = xs[j];
                v4u o; o.x = cvt_pk_bf16(a[0] * rc - bf_lo(x.x), a[1] * rc - bf_hi(x.x)); o.y = cvt_pk_bf16(a[2] * rc - bf_lo(x.y), a[3] * rc - bf_hi(x.y));
                o.z = cvt_pk_bf16(a[4] * rc - bf_lo(x.z), a[5] * rc - bf_hi(x.z)); o.w = cvt_pk_bf16(a[6] * rc - bf_lo(x.w), a[7] * rc - bf_hi(x.w));
                *(v4u*)(PL + (size_t)(row0 + r0 + j) * 512 + c8 * 8) = o; } }
    }
#undef POOL_ACC
}
__device__ __forceinline__ void ssm_scan(Frame& F) {
    const bf16* Z = (const bf16*)(F.ws + WS_Z); bf16* SP = (bf16*)(F.ws + WS_SP); const float* AT = (const float*)(F.ws + WS_AT);
    const int p = F.lane;
    for (int u = F.vcu + F.G * F.wave; u < 20 * NGRP * 2; u += F.G * NWAVES) {
        const int dir = u & 1, bg = u >> 1, g = bg & 31, b = bg >> 5;
        const int chunk0 = b < 16 ? b * 128 : 2048 + (b - 16) * 256, nch = b < 16 ? 128 : 256;
        const float ar = AT[((dir * NGRP + g) * 64 + p) * 2], ai = AT[((dir * NGRP + g) * 64 + p) * 2 + 1];
        const bf16* Zg = Z + ((size_t)g * NCHUNK + chunk0) * 256 + dir * 128 + p; bf16* Sg = SP + ((size_t)g * NCHUNK + chunk0) * 256 + dir * 128 + p;
        float sr = 0.f, si = 0.f;
        for (int c0 = 0; c0 < nch; c0 += 16) {
            float zr[16], zi[16];
#pragma unroll
            for (int k = 0; k < 16; ++k) { const int c = dir == 0 ? c0 + k : nch - 1 - (c0 + k); zr[k] = __uint_as_float((unsigned)Zg[(size_t)c * 256] << 16); zi[k] = __uint_as_float((unsigned)Zg[(size_t)c * 256 + 64] << 16); }
#pragma unroll
            for (int k = 0; k < 16; ++k) { const int c = dir == 0 ? c0 + k : nch - 1 - (c0 + k);
                Sg[(size_t)c * 256] = (bf16)(cvt_pk_bf16(sr, 0.f) & 0xffffu); Sg[(size_t)c * 256 + 64] = (bf16)(cvt_pk_bf16(si, 0.f) & 0xffffu);
                const float nr = ar * sr - ai * si + zr[k], ni = ar * si + ai * sr + zi[k]; sr = nr; si = ni; }
        }
    }
}
namespace att {
constexpr int KRING = 0, VRING = 49152;
constexpr int XOFF = 0, OSOFF = 65536, GOFF = OSOFF + 4 * 32 * 272, LDS_USED = GOFF + 512;
constexpr float THR = 8.f;
__device__ __forceinline__ int crow(int r, int hi) { return (r & 3) + 8 * (r >> 2) + 4 * hi; }
__device__ __forceinline__ int swap23(int x) { return (x & ~12) | ((x & 4) << 1) | ((x & 8) >> 1); }
__device__ __forceinline__ float swapf_max(float v) { auto rr = __builtin_amdgcn_permlane32_swap(__float_as_uint(v), __float_as_uint(v), false, false); return fmaxf(__uint_as_float(rr[0]), __uint_as_float(rr[1])); }
__device__ __forceinline__ float swapf_add(float v) { auto rr = __builtin_amdgcn_permlane32_swap(__float_as_uint(v), __float_as_uint(v), false, false); return __uint_as_float(rr[0]) + __uint_as_float(rr[1]); }
__device__ __forceinline__ bf16x8 pack_p(const f32x16& p, int s) { v4u w; w.x = cvt_pk_bf16(p[8 * s], p[8 * s + 1]); w.y = cvt_pk_bf16(p[8 * s + 2], p[8 * s + 3]); w.z = cvt_pk_bf16(p[8 * s + 4], p[8 * s + 5]); w.w = cvt_pk_bf16(p[8 * s + 6], p[8 * s + 7]); return __builtin_bit_cast(bf16x8, w); }

__device__ __forceinline__ void attn_unit(const bf16* __restrict__ Q, const bf16* __restrict__ K, const bf16* __restrict__ VT, bf16* __restrict__ O, const float* subg, float lam, int layer,
                                          int seq0, int L, int h, int qb, LAS unsigned char* lds, int wave_) {
#define FRESH_TID(t) int t; { unsigned z_ = 0u; asm volatile("" : "+v"(z_)); t = wave_ * 64 + (int)__builtin_amdgcn_mbcnt_hi(~0u, __builtin_amdgcn_mbcnt_lo(~0u, z_)); asm volatile("" : "+v"(t)); }
    FRESH_TID(tid_);
    const int wid = __builtin_amdgcn_readfirstlane(tid_ >> 6), comp = wid >> 2, wq = wid & 3;
    f32x16 o[4]; float l_run = 0.f;
    {
    const int tid = tid_, lane = tid & 63, r32 = lane & 31, hi = lane >> 5;
    unsigned koff[2], voff[2];
    const bf16* Kb = K + (size_t)seq0 * 1024 + h * 128; const bf16* Vb = VT + (size_t)(seq0 >> 8) * (1024 * 256) + (size_t)(h * 128) * 256;
#pragma unroll
    for (int i = 0; i < 2; ++i) { const int pc = wid + 8 * i;
        { const int row = (pc & 7) * 8 + (lane >> 3), c = (lane & 7) ^ ((row >> 1) & 7); koff[i] = 2u * (unsigned)(swap23(row) * 1024 + (pc >> 3) * 64 + c * 8); }
        { const int d = pc * 8 + (lane >> 3), c = (lane & 7) ^ ((d >> 1) & 7); voff[i] = 2u * (unsigned)(d * 256 + c * 8); } }
    const unsigned lds_u32 = (unsigned)(uintptr_t)lds + (unsigned)wid * 1024u;
#define DMA_K(t, slot) do { const bf16* kt_ = Kb + (size_t)(t) * 64 * 1024; asm volatile("" : "+s"(kt_));     \
        _Pragma("unroll") for (int i = 0; i < 2; ++i) pg8::glds_saddr(kt_, koff[i], lds_u32 + (unsigned)(KRING + (slot) * 16384 + i * 8192)); } while (0)
#define DMA_V(t, slot) do { const bf16* vt_ = Vb + (size_t)((t) >> 2) * (1024 * 256) + ((t) & 3) * 64; asm volatile("" : "+s"(vt_)); \
        _Pragma("unroll") for (int i = 0; i < 2; ++i) pg8::glds_saddr(vt_, voff[i], lds_u32 + (unsigned)(VRING + (slot) * 16384 + i * 8192)); } while (0)
#define WAIT_BAR() do { asm volatile("s_waitcnt vmcnt(0) lgkmcnt(0)" ::: "memory"); __builtin_amdgcn_s_barrier(); asm volatile("" ::: "memory"); } while (0)
#define WAIT_BAR_N(n) do { asm volatile("s_waitcnt vmcnt(" #n ") lgkmcnt(0)" ::: "memory"); __builtin_amdgcn_s_barrier(); asm volatile("" ::: "memory"); } while (0)
    const int NT = L / 64;
    __syncthreads();
    DMA_K(0, 0); DMA_K(1, 1); DMA_K(2, 2); DMA_V(0, 0);
    bf16x8 qf[4];
    { const bf16* qp = Q + (size_t)(seq0 + qb * 128 + wq * 32 + r32) * 1024 + h * 128 + comp * 64 + hi * 8;
#pragma unroll
      for (int s = 0; s < 4; ++s) qf[s] = *(const bf16x8*)(qp + s * 16); }
    const int sw = (r32 >> 1) & 7; const LAS unsigned char* kbs[4]; const LAS unsigned char* vbs[4];
#pragma unroll
    for (int s = 0; s < 4; ++s) { const int fo = r32 * 128 + (((2 * s + hi) ^ sw) << 4); kbs[s] = lds + KRING + comp * 8192 + fo; vbs[s] = lds + VRING + fo; }
#pragma unroll
    for (int d = 0; d < 4; ++d)
#pragma unroll
        for (int r = 0; r < 16; ++r) o[d][r] = 0.f;
    float m_run = 0.f, alpha = 1.f; bool resc = false; const float thr_ = THR;
    f32x16 pA, pB, pC, pD;
    f32x16 negm;
    v4u pw[4];
    bf16x8 kf[8];
#define SBAR() __builtin_amdgcn_sched_barrier(0)
#define PIN(x) asm volatile("" : "+v"(x))
#define USE(x) asm volatile("" :: "v"(x))
#define SGB(mask, n) __builtin_amdgcn_sched_group_barrier((mask), (n), 0)
#define KFR(kh, s) (*(const LAS bf16x8*)(kbs[s] + (kb_ + (kh) * 4096)))
#define VFR(d, s) (*(const LAS bf16x8*)(vbs[s] + (vb_ + (d) * 4096)))
#define MFMA32(a, b, c) __builtin_amdgcn_mfma_f32_32x32x16_bf16((a), (b), (c), 0, 0, 0)
#define GAPA(C, CIN, kh, s, P, B, W) do { C = MFMA32(kf[(s) * 2 + (kh)], qf[s], CIN); PIN(C); \
        pw[W][((B) >> 1) & 3] = cvt_pk_bf16(P[B], P[B + 1]); pw[W][(((B) >> 1) & 3) + 1] = cvt_pk_bf16(P[B + 2], P[B + 3]); \
        l_run += P[B]; l_run += P[B + 1]; l_run += P[B + 2]; l_run += P[B + 3]; USE(l_run); SBAR(); } while (0)
#define PVM(d, s) o[d] = MFMA32(vf[((d) & 1) * 4 + (s)], __builtin_bit_cast(bf16x8, pw[s]), o[d])
#define MAXF(X, B) "v"(X[B]), "v"(X[B + 1]), "v"(X[B + 2]), "v"(X[B + 3]), "v"(X[B + 4]), "v"(X[B + 5]), "v"(X[B + 6]), "v"(X[B + 7])
#define GAPM_FIRST(d, s, X, B) do { PVM(d, s); asm("v_max3_f32 %0, %2, %3, %4\n\tv_max3_f32 %1, %5, %6, %7\n\tv_max3_f32 %0, %0, %8, %9" : "=&v"(mxa), "=&v"(mxb) : MAXF(X, B)); SBAR(); } while (0)
#define GAPM(d, s, X, B) do { PVM(d, s); asm("v_max3_f32 %0, %0, %2, %3\n\tv_max3_f32 %1, %1, %4, %5\n\tv_max3_f32 %0, %0, %6, %7\n\tv_max3_f32 %1, %1, %8, %9" : "+v"(mxa), "+v"(mxb) : MAXF(X, B)); SBAR(); } while (0)
#define GAPM_LAST(d, s, X, B) do { PVM(d, s); asm("v_max3_f32 %0, %0, %3, %4\n\tv_max3_f32 %1, %1, %5, %6\n\tv_max3_f32 %0, %0, %7, %8\n\tv_max3_f32 %1, %1, %9, %10\n\tv_max_f32 %0, %0, %1\n\tv_cmp_nle_f32 %2, %0, %11" \
        : "+v"(mxa), "+v"(mxb), "=s"(over) : MAXF(X, B), "s"(thr_)); SBAR(); } while (0)
#define GAPE3(d, s, X, B) do { PVM(d, s); X[B] = __builtin_amdgcn_exp2f(X[B]); X[B + 1] = __builtin_amdgcn_exp2f(X[B + 1]); X[B + 2] = __builtin_amdgcn_exp2f(X[B + 2]); PIN(X); SBAR(); } while (0)
#define GAPE2(d, s, X, B) do { PVM(d, s); X[B] = __builtin_amdgcn_exp2f(X[B]); X[B + 1] = __builtin_amdgcn_exp2f(X[B + 1]); PIN(X); SBAR(); } while (0)
#define DECIDE(C0, C1) do { resc = false; \
        if (__builtin_expect(over != 0ull, 0)) { const float mx = swapf_max(mxa); const float dl = fmaxf(mx, 0.f); alpha = __builtin_amdgcn_exp2f(-dl); m_run += dl; l_run *= alpha; resc = true; \
            _Pragma("unroll") for (int r = 0; r < 16; ++r) { C0[r] -= dl; C1[r] -= dl; negm[r] -= dl; } } } while (0)
#define RESCALE() do { if (resc) { _Pragma("unroll") for (int d = 0; d < 4; ++d) _Pragma("unroll") for (int r = 0; r < 16; ++r) o[d][r] *= alpha; } } while (0)
#define KPRE2(kslot, s0) do { constexpr int kb_ = (kslot) * 16384; _Pragma("unroll") for (int s = (s0); s < (s0) + 2; ++s) { kf[2 * s] = KFR(0, s); kf[2 * s + 1] = KFR(1, s); } } while (0)
#define PHASE_A(C0, C1, P0, P1, vslot) do { \
        constexpr int vb_ = (vslot) * 16384; \
        SBAR(); \
        GAPA(C0, negm, 0, 0, P0, 0, 0); GAPA(C1, negm, 1, 0, P0, 4, 0); \
        GAPA(C0, C0, 0, 1, P0, 8, 1); GAPA(C1, C1, 1, 1, P0, 12, 1); \
        GAPA(C0, C0, 0, 2, P1, 0, 2); GAPA(C1, C1, 1, 2, P1, 4, 2); \
        _Pragma("unroll") for (int s = 0; s < 4; ++s) vf[s] = VFR(0, s); SBAR();        \
        GAPA(C0, C0, 0, 3, P1, 8, 3); GAPA(C1, C1, 1, 3, P1, 12, 3); \
        } while (0)
#define PHASE_B(C0, C1, vslot, knext, pre) do { \
        constexpr int vb_ = (vslot) * 16384; \
        _Pragma("unroll") for (int s = 0; s < 4; ++s) vf[4 + s] = VFR(1, s); \
        float mxa, mxb; unsigned long long over; asm volatile("s_nop 15\n\ts_nop 7" : "+v"(C0), "+v"(C1)); SBAR(); \
        GAPM_FIRST(0, 0, C0, 0); GAPM(0, 1, C0, 8); GAPM(0, 2, C1, 0); GAPM_LAST(0, 3, C1, 8); \
        DECIDE(C0, C1); \
        _Pragma("unroll") for (int s = 0; s < 4; ++s) vf[s] = VFR(2, s); SBAR(); \
        GAPE3(1, 0, C0, 0); GAPE3(1, 1, C0, 3); GAPE3(1, 2, C0, 6); GAPE3(1, 3, C0, 9); \
        _Pragma("unroll") for (int s = 0; s < 4; ++s) vf[4 + s] = VFR(3, s); if (pre) KPRE2(knext, 0); SBAR(); \
        GAPE3(2, 0, C0, 12); C0[15] = __builtin_amdgcn_exp2f(C0[15]); GAPE3(2, 1, C1, 0); if (pre) KPRE2(knext, 2); SBAR(); GAPE3(2, 2, C1, 3); GAPE3(2, 3, C1, 6); \
        GAPE3(3, 0, C1, 9); GAPE2(3, 1, C1, 12); GAPE2(3, 2, C1, 14); PVM(3, 3); SBAR(); \
        RESCALE(); } while (0)
#define BOUNDARY(t, S0, SN) do { if ((t) + 2 < NT) WAIT_BAR_N(4); else WAIT_BAR_N(2); \
        if ((t) + 3 < NT) DMA_K((t) + 3, S0); if ((t) + 1 < NT) DMA_V((t) + 1, SN); } while (0)
#define STEP(C0, C1, P0, P1, t, S0, S1, SN) do { BOUNDARY((t), S0, SN); bf16x8 vf[8]; PHASE_A(C0, C1, P0, P1, S1); PHASE_B(C0, C1, S1, SN, ((t) + 1 < NT)); } while (0)
    WAIT_BAR();
    KPRE2(0, 0); KPRE2(0, 2);
    WAIT_BAR_N(0);
    DMA_K(3, 0); DMA_V(1, 1);
    {
#pragma unroll
      for (int r = 0; r < 16; ++r) { pA[r] = 0.f; pB[r] = 0.f; }
#pragma unroll
      for (int s = 0; s < 4; ++s) { pA = MFMA32(kf[2 * s], qf[s], pA); pB = MFMA32(kf[2 * s + 1], qf[s], pB); }
      SBAR(); KPRE2(1, 0); KPRE2(1, 2);
      float mx = fmaxf(pA[0], pB[0]);
#pragma unroll
      for (int r = 1; r < 16; ++r) mx = fmaxf(mx, fmaxf(pA[r], pB[r]));
      m_run = swapf_max(mx);
#pragma unroll
      for (int r = 0; r < 16; ++r) { pA[r] = __builtin_amdgcn_exp2f(pA[r] - m_run); pB[r] = __builtin_amdgcn_exp2f(pB[r] - m_run); negm[r] = -m_run; } }
    if (comp == 1) __builtin_amdgcn_s_setprio(1);
    int t = 1;
    for (; t + 6 < NT; t += 6) {
        STEP(pC, pD, pA, pB, t, 1, 0, 2); STEP(pA, pB, pC, pD, t + 1, 2, 1, 0); STEP(pC, pD, pA, pB, t + 2, 0, 2, 1);
        STEP(pA, pB, pC, pD, t + 3, 1, 0, 2); STEP(pC, pD, pA, pB, t + 4, 2, 1, 0); STEP(pA, pB, pC, pD, t + 5, 0, 2, 1); }
    if (NT == 64) { STEP(pC, pD, pA, pB, 61, 1, 0, 2); STEP(pA, pB, pC, pD, 62, 2, 1, 0); STEP(pC, pD, pA, pB, 63, 0, 2, 1); }
    else { STEP(pC, pD, pA, pB, 31, 1, 0, 2); }
    __builtin_amdgcn_s_setprio(0);
    WAIT_BAR();
    const int vs_last = (NT == 64) ? 0 : 1;
    { const int vb_ = vs_last * 16384;
      float sacc = 0.f;
#pragma unroll
      for (int r = 0; r < 16; ++r) sacc += pC[r] + pD[r];
      l_run += sacc;
      bf16x8 pa[4]; pa[0] = pack_p(pC, 0); pa[1] = pack_p(pC, 1); pa[2] = pack_p(pD, 0); pa[3] = pack_p(pD, 1);
#pragma unroll
      for (int d = 0; d < 4; ++d)
#pragma unroll
          for (int s = 0; s < 4; ++s) o[d] = __builtin_amdgcn_mfma_f32_32x32x16_bf16(VFR(d, s), pa[s], o[d], 0, 0, 0); }
#undef DMA_K
#undef DMA_V
#undef STEP
#undef BOUNDARY
#undef PHASE_A
#undef PHASE_B
#undef KPRE2
#undef GAPA
#undef GAPM
#undef MAXF
#undef GAPM_FIRST
#undef GAPM_LAST
#undef GAPE3
#undef GAPE2
#undef PVM
#undef DECIDE
#undef RESCALE
#undef PIN
#undef USE
#undef SGB
#undef KFR
#undef VFR
    }
    WAIT_BAR();
    FRESH_TID(te_);
#undef FRESH_TID
    const int tid = te_, lane = tid & 63, r32 = lane & 31, hi = lane >> 5;
    const float inv = 1.f / swapf_add(l_run);
    LAS float* X = (LAS float*)(lds + XOFF); LAS float* Gt = (LAS float*)(lds + GOFF);
    if (comp == 1) { const float f = lam * inv;
#pragma unroll
        for (int d = 0; d < 4; ++d)
#pragma unroll
            for (int r = 0; r < 16; ++r) X[(wq * 128 + 32 * d + crow(r, hi)) * 32 + r32] = o[d][r] * f; }
    { int l_ = layer; asm volatile("" : "+s"(l_)); if (tid < 128) Gt[tid] = subg[tid] * (1.f - (0.8f - 0.6f * __expf(-0.3f * (float)l_))); }
    __syncthreads();
    if (comp == 0) {
        float ss = 0.f;
#pragma unroll
        for (int d = 0; d < 4; ++d)
#pragma unroll
            for (int r = 0; r < 16; ++r) { const float v = o[d][r] * inv - X[(wq * 128 + 32 * d + crow(r, hi)) * 32 + r32]; o[d][r] = v; ss += v * v; }
        ss = swapf_add(ss);
        const float rs = rsqrtf(ss * (1.f / 128.f) + RMS_EPS);
        LAS unsigned char* os = lds + OSOFF + wq * (32 * 272);
#pragma unroll
        for (int d = 0; d < 4; ++d)
#pragma unroll
            for (int rg = 0; rg < 4; ++rg) { const int d0 = 32 * d + 8 * rg + 4 * hi; const f32x4 gg = *(const LAS f32x4*)(Gt + d0);
                v2u w; w.x = cvt_pk_bf16(o[d][4 * rg] * rs * gg.x, o[d][4 * rg + 1] * rs * gg.y); w.y = cvt_pk_bf16(o[d][4 * rg + 2] * rs * gg.z, o[d][4 * rg + 3] * rs * gg.w);
                *(LAS v2u*)(os + r32 * 272 + d0 * 2) = w; }
        LDS_WAIT(); asm volatile("" ::: "memory");
        bf16* Ow = O + (size_t)(seq0 + qb * 128 + wq * 32) * DM + h * 128;
#pragma unroll
        for (int i = 0; i < 8; ++i) { const int cid = lane + 64 * i, row = cid >> 4, c16 = cid & 15; const v4u v = *(const LAS v4u*)(os + row * 272 + c16 * 16); *(v4u*)(Ow + (size_t)row * DM + c16 * 8) = v; }
    }
}
struct APtrs { const float *q1, *k1, *q2, *k2, *subln; };
__device__ __forceinline__ void attn_phase(Frame& F, const APtrs& A, int l) {
    const bf16* Q = (const bf16*)(F.ws + WS_Q); const bf16* K = (const bf16*)(F.ws + WS_K); const bf16* VT = (const bf16*)(F.ws + WS_VT); bf16* MIX = (bf16*)(F.ws + WS_HB);
    const float lam_init = 0.8f - 0.6f * expf(-0.3f * (float)l);
    float d1 = 0.f, d2 = 0.f;
    for (int i = 0; i < 64; ++i) { d1 += A.q1[l * 64 + i] * A.k1[l * 64 + i]; d2 += A.q2[l * 64 + i] * A.k2[l * 64 + i]; }
    const float lam = __builtin_bit_cast(float, __builtin_amdgcn_readfirstlane(__builtin_bit_cast(int, expf(d1) - expf(d2) + lam_init)));
    const float* subg = A.subln + l * 128;
    for (int U = F.vcu; U < 1024; U += F.G) { const int bh = U >> 5, qb = U & 31, b = bh >> 3, h = bh & 7; attn_unit(Q, K, VT, MIX, subg, lam, l, NPROMPT + b * 4096, 4096, h, qb, F.lds, F.wave); }
    for (int U = F.vcu; U < 2048; U += F.G) { const int bh = U >> 4, qb = U & 15, b = bh >> 3, h = bh & 7; attn_unit(Q, K, VT, MIX, subg, lam, l, b * 2048, 2048, h, qb, F.lds, F.wave); }
    __syncthreads();
}
}
#ifndef UP_ALIGN
#define UP_ALIGN true
#endif
#ifndef FFN_SP2
#define FFN_SP2 true
#endif
constexpr int NSLAB = 6, SLAB_ROWS = NTOK / NSLAB  , SLAB_PANELS = SLAB_ROWS / 256;
constexpr int PH_PER_LAYER = 7 + NSLAB + 1, NPHASE = 1 + NLAYER * PH_PER_LAYER + 1;
struct Args { const float* in[26]; float* out; unsigned char* ws; int ph_lo, ph_hi, use_bar, pad; };
typedef __attribute__((address_space(4))) const unsigned char* KP;
template <class T> __device__ __forceinline__ T karg(KP kp, int off) { typedef T TT; return *(const __attribute__((address_space(4))) TT*)(kp + off); }
#define KARG(T, off) karg<T>(kp, (off))
__global__ void __launch_bounds__(NWAVES * 64, 2) fwd_kernel(Args args) {
    extern __shared__ __attribute__((aligned(16))) unsigned char lds_raw[];
    Frame F;
    F.lds = (LAS unsigned char*)lds_raw;
    F.tid = threadIdx.x; F.lane = F.tid & 63; F.wave = __builtin_amdgcn_readfirstlane(F.tid >> 6);
    F.G = gridDim.x; { const int bx = blockIdx.x; F.vcu = (F.G % 8 == 0) ? (bx % 8) * (F.G / 8) + bx / 8 : bx; }
    KP kp0 = (KP)__builtin_amdgcn_kernarg_segment_ptr();
    static_assert(sizeof(Args) == 240, "Args layout");
    F.out = nullptr; F.ws = nullptr;
    volatile LAS unsigned* MISC = (volatile LAS unsigned*)(F.lds + MISC_OFF);
    for (int u = F.tid; u < (LDS_BYTES - LDSCTL_OFF) / 4; u += NWAVES * 64) ((LAS unsigned*)(F.lds + LDSCTL_OFF))[u] = 0u;
    __syncthreads();
    KP kp = kp0; asm volatile("" : "+s"(kp));
    unsigned* barw = (unsigned*)(KARG(unsigned char*, 216) + WS_CTL) + CW_BAR;
    XcdBarrier bar; bar.bar = barw; bar.x = 0; bar.st = nullptr;
    if (KARG(int, 232)) bar = xcd_barrier_post(barw, MISC + 8);
    const int lo = KARG(int, 224), hi = KARG(int, 228);
#define IN(k) (lo <= (k) && (k) < hi)
#define SEAM(k) do { if (IN(k) && IN((k) + 1)) xcd_barrier(bar); } while (0)
#define PHASE_FRAME() Frame P; KP kp = kp0; { int g_ = __builtin_amdgcn_readfirstlane(F.G), v_ = __builtin_amdgcn_readfirstlane(F.vcu), w_ = F.wave, c_ = __builtin_amdgcn_readfirstlane((int)blockIdx.x); \
        asm volatile("" : "+s"(kp), "+s"(g_), "+s"(v_), "+s"(w_), "+s"(c_)); \
        unsigned z_ = 0u; asm volatile("" : "+v"(z_)); int t_ = w_ * 64 + (int)__builtin_amdgcn_mbcnt_hi(~0u, __builtin_amdgcn_mbcnt_lo(~0u, z_)); asm volatile("" : "+v"(t_)); \
        P.out = KARG(float*, 208); P.ws = KARG(unsigned char*, 216); P.G = g_; P.vcu = v_; P.tid = t_; P.lane = t_ & 63; P.wave = w_; P.lds = F.lds; cblk = c_; } \
        LAS unsigned char* ring = P.lds
#define AIN(k) KARG(const float*, 8 * (k))
#define WPTRS() WPtrs WP{AIN(3), AIN(21), AIN(17), AIN(19), AIN(20), AIN(23), AIN(24), AIN(2), AIN(22)}
#define SPTRS() SPtrs SS{AIN(9), AIN(10), AIN(11), AIN(12), AIN(13), AIN(14), AIN(15), AIN(16)}
#define WSP(T, off) ((T*)(P.ws + (off)))
#define SS1(l) (WSP(unsigned long long, WS_SS) + (size_t)(l) * NTOK)
#define SS2(l) (WSP(unsigned long long, WS_SS) + (size_t)(5 + (l)) * NTOK)
#define X1P ((bf16*)P.out)
#define X2P ((bf16*)P.out + (size_t)NTOK * DM)
    int cblk = 0;
    if (IN(0)) { PHASE_FRAME(); (void)ring; WPTRS(); SPTRS();
        if (P.G >= 2 * NGRP) { if (cblk >= NGRP) convert_weights(P, WP, 0, 7, cblk - NGRP, P.G - NGRP); else ssm_weights(P, SS, 0); __syncthreads(); }
        else { convert_weights(P, WP, 0, 7, cblk, P.G); __syncthreads(); ssm_weights(P, SS, 0); }
        input_rows(P, AIN(0), AIN(1), X1P, SS1(0));
        SEAM(0);
    }
    for (int l = 0; l < NLAYER; ++l) {
        const int pb = 1 + l * PH_PER_LAYER;
        if (IN(pb + 0)) { PHASE_FRAME();
            if (l > 0) { WPTRS(); convert_weights(P, WP, l, 2, cblk, P.G); __syncthreads(); }
            { pg8::Gemm g{X1P, WSP(bf16, WS_WIN), NTOK, 3072, DM}; pg8::SchedX<1> S; S.init(NTOK, 3072, P.G, cblk); S.off = 0;
              pg8::EpiInProj E{WSP(bf16, WS_Q), WSP(bf16, WS_K), WSP(bf16, WS_US), WSP(bf16, WS_UP), WSP(const float, WS_ROPE), SS1(l)};
              pg8::gemm_phase<pg8::EpiInProj, pg8::SchedX<1>, true, true>(ring, g, S, E, P.tid); }
            { pg8::Gemm g{WSP(bf16, WS_WIN) + (size_t)2048 * DM, X1P, 1024, NTOK, DM}; pg8::SchedX<0> S; S.init(1024, NTOK, P.G, cblk); S.off = 0;
              pg8::EpiVT E{WSP(bf16, WS_VT), SS1(l)};
              pg8::gemm_phase<pg8::EpiVT, pg8::SchedX<0>, true, true>(ring, g, S, E, P.tid); }
            SEAM(pb + 0);
        }
        if (IN(pb + 1)) { PHASE_FRAME(); int kssm = 256; asm volatile("" : "+s"(kssm));
            { pg8::Gemm g{WSP(bf16, WS_US), WSP(bf16, WS_SSM1), NGRP * NCHUNK, 512, kssm}; pg8::SchedX<2> S; S.init(NGRP * NCHUNK, 512, P.G, cblk); S.off = 0;
              pg8::EpiSsm1 E{WSP(bf16, WS_YI), (size_t)(WS_Z - WS_YI) / 2};
              pg8::gemm_phase<pg8::EpiSsm1, pg8::SchedX<2>, true, true>(ring, g, S, E, P.tid); }
            SEAM(pb + 1);
        }
        if (IN(pb + 2)) { PHASE_FRAME(); (void)ring; ssm_scan(P); pool_prepass(P); SEAM(pb + 2); }
        if (IN(pb + 3)) { PHASE_FRAME(); int kssm = 256; asm volatile("" : "+s"(kssm));
            { pg8::Gemm g{WSP(bf16, WS_SP), WSP(bf16, WS_SSM2), NGRP * NCHUNK, 256, kssm}; pg8::SchedX<3> S; S.init(NGRP * NCHUNK, 256, P.G, cblk); S.off = 0;
              pg8::EpiSsm2 E{WSP(bf16, WS_YI), WSP(bf16, WS_ZB)};
              pg8::gemm_phase<pg8::EpiSsm2, pg8::SchedX<3>, true, true>(ring, g, S, E, P.tid); }
            SEAM(pb + 3);
        }
        if (IN(pb + 4)) { PHASE_FRAME();
            { pg8::Gemm g{WSP(bf16, WS_ZB), WSP(bf16, WS_GP), 2 * NTOK, 1024, 512}; pg8::SchedX<4> S; S.init(NTOK, 1024, P.G, cblk); S.off = 0;
              pg8::EpiGluPool E{WSP(bf16, WS_ZB), AIN(18) + (size_t)l * 512, WSP(bf16, WS_HB)};
              pg8::gemm_phase<pg8::EpiGluPool, pg8::SchedX<4>, true, true>(ring, g, S, E, P.tid); }
            if (!IN(pb + 5)) SEAM(pb + 4);
        }
        if (IN(pb + 5)) { PHASE_FRAME(); (void)ring; att::APtrs AP{AIN(4), AIN(5), AIN(6), AIN(7), AIN(8)}; att::attn_phase(P, AP, l); SEAM(pb + 5); }
        if (IN(pb + 6)) { PHASE_FRAME();
            { pg8::Gemm g{WSP(bf16, WS_HB), WSP(bf16, WS_WOUT), NTOK, DM, DM}; pg8::SchedX<0> S; S.init(NTOK, DM, P.G, cblk); S.off = 0;
              pg8::EpiResidX E{X1P, X2P, SS2(l), 0};
              pg8::gemm_phase<pg8::EpiResidX, pg8::SchedX<0>, true, true>(ring, g, S, E, P.tid); }
            SEAM(pb + 6);
        }
        for (int s = 0; s <= NSLAB; ++s) {
            if (IN(pb + 7 + s)) { PHASE_FRAME();
                if (s == 0 && l + 1 < NLAYER) { WPTRS(); SPTRS();
                    if (P.G >= 2 * NGRP) { if (cblk >= NGRP) convert_weights(P, WP, l + 1, 1, cblk - NGRP, P.G - NGRP); else ssm_weights(P, SS, l + 1); __syncthreads(); }
                    else { convert_weights(P, WP, l + 1, 1, cblk, P.G); __syncthreads(); ssm_weights(P, SS, l + 1); __syncthreads(); } }
                const int par = 0;
#pragma unroll 1
                for (int k = 0; k < 2; ++k) { int kk = k ^ par; asm volatile("" : "+s"(kk));
                    if (kk == 0) { if (s > 0) { const int sd = s - 1;
                        pg8::Gemm g{WSP(bf16, WS_HID) + (size_t)(sd & 1) * ((size_t)SLAB_ROWS * DFF), WSP(bf16, WS_WDN), SLAB_ROWS, DM, DFF}; pg8::SchedX<0> S; S.init(SLAB_ROWS, DM, P.G, cblk); S.off = 0;
                        pg8::EpiResidX E{X2P, l + 1 < NLAYER ? X1P : WSP(bf16, WS_HB), SS1(l + 1), sd * SLAB_ROWS};
                        pg8::gemm_phase<pg8::EpiResidX, pg8::SchedX<0>, true, FFN_SP2>(ring, g, S, E, P.tid); } }
                    else { if (s < NSLAB) {
                        pg8::Gemm g{X2P, WSP(bf16, WS_WUP), NTOK, DFF, DM}; pg8::SchedX<0> S; S.init(SLAB_ROWS, DFF, P.G, cblk); S.off = s * SLAB_PANELS;
                        pg8::EpiSqRelu E{WSP(bf16, WS_HID) + (size_t)(s & 1) * ((size_t)SLAB_ROWS * DFF), s * SLAB_ROWS, SS2(l)};
                        pg8::gemm_phase<pg8::EpiSqRelu, pg8::SchedX<0>, UP_ALIGN, FFN_SP2>(ring, g, S, E, P.tid); } }
                }
                SEAM(pb + 7 + s);
            }
        }
    }
    if (IN(NPHASE - 1)) { PHASE_FRAME(); (void)ring; final_norm(P, WSP(bf16, WS_HB), AIN(25), SS1(NLAYER)); }
#undef IN
#undef SEAM
}

#ifndef MK_ONE_LAUNCH
#define MK_ONE_LAUNCH 1
#endif
extern "C" void kernel_launch(void* const* d_in, const int* in_sizes, int n_in, void* d_out, int out_size, void* d_ws, size_t ws_size, hipStream_t stream) {
    static int grid = 0;
    if (grid == 0) {
        if (n_in != 26 || out_size != NTOK * DM || ws_size < WS_END) { fprintf(stderr, "kernel_launch: unexpected shapes: n_in %d out %d ws %zu (need %zu)\n", n_in, out_size, ws_size, (size_t)WS_END); grid = -1; return; }
        int dev = 0, cus = 0, per_cu = 0;
        if (hipGetDevice(&dev) != hipSuccess || hipDeviceGetAttribute(&cus, hipDeviceAttributeMultiprocessorCount, dev) != hipSuccess) { grid = -1; return; }
        if (hipFuncSetAttribute((const void*)fwd_kernel, hipFuncAttributeMaxDynamicSharedMemorySize, LDS_BYTES) != hipSuccess) { fprintf(stderr, "kernel_launch: hipFuncSetAttribute failed\n"); grid = -1; return; }
        if (hipOccupancyMaxActiveBlocksPerMultiprocessor(&per_cu, (const void*)fwd_kernel, NWAVES * 64, LDS_BYTES) != hipSuccess || per_cu < 1) fprintf(stderr, "kernel_launch: occupancy query reports %d\n", per_cu);
        (void)hipGetLastError();
        grid = cus;
    }
    if (grid < 0) return;
    if (hipMemsetAsync((char*)d_ws + WS_CTL, 0, CTL_ZERO_BYTES, stream) != hipSuccess) return;
    if (hipMemsetAsync((char*)d_ws + WS_SS, 0, SS_BYTES, stream) != hipSuccess) return;
    Args a{};
    for (int i = 0; i < 26; ++i) a.in[i] = (const float*)d_in[i];
    a.out = (float*)d_out; a.ws = (unsigned char*)d_ws; a.pad = 0;
#if MK_ONE_LAUNCH
    a.ph_lo = 0; a.ph_hi = NPHASE; a.use_bar = 1;
    hipLaunchKernelGGL(fwd_kernel, dim3(grid), dim3(NWAVES * 64), LDS_BYTES, stream, a);
#else
    a.use_bar = 0;
    for (int p = 0; p < NPHASE; ++p) { a.ph_lo = p; a.ph_hi = p + 1; hipLaunchKernelGGL(fwd_kernel, dim3(grid), dim3(NWAVES * 64), LDS_BYTES, stream, a); }
#endif
    const hipError_t le = hipPeekAtLastError();
    if (le != hipSuccess) fprintf(stderr, "kernel_launch: launch failed: %s\n", hipGetErrorName(le));
}
```

```cpp
#include <hip/hip_runtime.h>
#include <hip/hip_bf16.h>
#include <cstdio>
#include <cstdint>
#include <cmath>
constexpr int DM = 2048, NTOK = 49152, NPROMPT = 32768, NLAYER = 4, DFF = 8192;
constexpr int CH_T = 16, NCHUNK = NTOK / CH_T  , NGRP = 32;
constexpr float QSCALE = 0.125f * 1.4426950408889634f;
constexpr float RMS_EPS = 1e-6f;

namespace pg8 {
#define PG8_LAS __attribute__((address_space(3)))
typedef unsigned short bf16_t;
typedef short bf16x8 __attribute__((ext_vector_type(8)));
typedef float f32x4 __attribute__((ext_vector_type(4)));
typedef unsigned u32x4 __attribute__((ext_vector_type(4)));
constexpr int BM = 256, BK = 64, HALF = 128, HTB = HALF * BK * 2  , STAGE_BYTES = 8 * HTB, NXCD = 8, WGM = 8;

__device__ __forceinline__ void glds_saddr(const void* sbase, unsigned voff, unsigned lds_addr) {
    asm volatile("s_mov_b32 m0, %2\n\ts_nop 3\n\tglobal_load_lds_dwordx4 %0, %1" :: "v"(voff), "s"(sbase), "s"(lds_addr) : "memory");
}
__host__ __device__ __forceinline__ int lds_byte(int r, int c) { const int st = (r >> 4) * 2 + (c >> 5), rr = r & 15, cc = c & 31, ob = rr * 64 + cc * 2; return st * 1024 + (ob ^ (((ob >> 9) & 1) << 5)); }
__host__ __device__ __forceinline__ void stage_rc(int b, int& R, int& C) { const int st = b / 1024, sb = b % 1024, swz = sb ^ (((sb >> 9) & 1) << 5); R = (st >> 1) * 16 + swz / 64; C = (st & 1) * 32 + (swz % 64) / 2; }
__host__ __device__ __forceinline__ int perm32(int rho) { const int n = rho >> 4, i = rho & 15; return 8 * (i >> 2) + 4 * n + (i & 3); }

struct Unit { int pm, pn; };
struct Gemm { const bf16_t* A; const bf16_t* Bt; int M, N, K; };

struct StaticOrder {
    int nM, nN, nwg, G, c;
    __host__ __device__ void init(int M, int N, int G_, int c_) { nM = M / BM; nN = N / BM; nwg = nM * nN; G = G_; c = c_; }
    __host__ __device__ bool next(int i, Unit& u) const {
        const long L = (long)i * G + c; if (L >= nwg) return false;
        int wgid = (int)L; { const int q = nwg / NXCD, r = nwg % NXCD, xcd = wgid % NXCD, off = wgid / NXCD; wgid = (xcd < r ? xcd * (q + 1) : r * (q + 1) + (xcd - r) * q) + off; }
        const int nig = WGM * nN, gid = wgid / nig, fm = gid * WGM, gsz = (nM - fm) < WGM ? (nM - fm) : WGM;
        u.pm = fm + ((wgid % nig) % gsz); u.pn = (wgid % nig) / gsz; return true;
    }
    __device__ __forceinline__ void a_ready(const Unit&) const {}
    __device__ __forceinline__ void done(const Unit&) const {}
};
template <int MODE> struct SchedX : StaticOrder {
    int off;
    __device__ __forceinline__ bool next(int i, Unit& u) const {
        if (!StaticOrder::next(i, u)) return false;
        if (MODE == 0) u.pm += off;
        if (MODE == 1) u.pn = u.pn < 8 ? u.pn : u.pn + 4;
        if (MODE == 2) u.pn = (u.pm / 12) * 2 + u.pn;
        if (MODE == 3) u.pn = u.pm / 12;
        if (MODE == 4) { if (u.pn >= 2) u.pm += 192; }
        return true;
    }
};

typedef float f32x2 __attribute__((ext_vector_type(2))); typedef __bf16 bf16x2_t __attribute__((ext_vector_type(2))); typedef unsigned u32x2 __attribute__((ext_vector_type(2)));
__device__ __forceinline__ unsigned cvt_pk_bf16(float lo, float hi) { f32x2 v = {lo, hi}; bf16x2_t b = __builtin_convertvector(v, bf16x2_t); return __builtin_bit_cast(unsigned, b); }
__device__ __forceinline__ float sum_xor16(float v) { auto r = __builtin_amdgcn_permlane16_swap(__float_as_uint(v), __float_as_uint(v), false, false); return __uint_as_float(r[0]) + __uint_as_float(r[1]); }
__device__ __forceinline__ float sum_xor32(float v) { auto r = __builtin_amdgcn_permlane32_swap(__float_as_uint(v), __float_as_uint(v), false, false); return __uint_as_float(r[0]) + __uint_as_float(r[1]); }
__device__ __forceinline__ float get_xor16(float v, bool odd_row) { auto r = __builtin_amdgcn_permlane16_swap(__float_as_uint(v), __float_as_uint(v), false, false); return __uint_as_float(odd_row ? r[0] : r[1]); }
__device__ __forceinline__ float bf_lo(unsigned w) { return __uint_as_float(w << 16); }
__device__ __forceinline__ float bf_hi(unsigned w) { return __uint_as_float(w & 0xffff0000u); }
__device__ __forceinline__ u32x4 pack8(f32x4 a, f32x4 b) { u32x4 w; w.x = cvt_pk_bf16(a[0], a[1]); w.y = cvt_pk_bf16(a[2], a[3]); w.z = cvt_pk_bf16(b[0], b[1]); w.w = cvt_pk_bf16(b[2], b[3]); return w; }

__device__ __forceinline__ float rstd_of(unsigned long long ss) { return __builtin_amdgcn_rsqf((float)ss * (1.f / (1048576.f * DM)) + RMS_EPS); }
struct EpiVT { static constexpr bool PERM = true, AFTER_DRAIN = false; static constexpr bool PERM2 = false; static constexpr int NVM = 16;
    bf16_t* O; const unsigned long long* SS;
    __device__ __forceinline__ void operator()(const f32x4 (&acc)[2][2][4][2], const Unit& u, int wr, int wc, int fr, int fq) const {
        asm volatile("" : "+v"(fr), "+v"(fq));
        const int row0 = u.pm * BM + wr * 64 + fr, cl0 = wc * 32 + 8 * fq, col0 = u.pn * BM + cl0;
        f32x4 r0[2], r1[2];
#pragma unroll
        for (int bj = 0; bj < 2; ++bj)
#pragma unroll
            for (int i = 0; i < 4; ++i) { r0[bj][i] = rstd_of(SS[col0 + bj * HALF + i]); r1[bj][i] = rstd_of(SS[col0 + bj * HALF + 4 + i]); }
        bf16_t* tile = O + (size_t)u.pn * (1024 * 256);
#pragma unroll
        for (int ai = 0; ai < 2; ++ai)
#pragma unroll
            for (int m = 0; m < 4; ++m) { bf16_t* rowp = tile + (size_t)(row0 + ai * HALF + m * 16) * 256 + cl0;
#pragma unroll
                for (int bj = 0; bj < 2; ++bj) *(u32x4*)(rowp + bj * HALF) = pack8(acc[ai][bj][m][0] * r0[bj], acc[ai][bj][m][1] * r1[bj]); }
    }
};
struct EpiInProj { static constexpr bool PERM = true, AFTER_DRAIN = false; static constexpr bool PERM2 = false; static constexpr int NVM = 16;
    bf16_t *Q, *K, *US, *UP; const float* rope; const unsigned long long* SS;
    __device__ __forceinline__ void operator()(const f32x4 (&acc)[2][2][4][2], const Unit& u, int wr, int wc, int fr, int fq) const {
        asm volatile("" : "+v"(fr), "+v"(fq));
        const int pn = u.pn, row0 = u.pm * BM + wr * 64 + fr, cw = wc * 32 + 8 * fq;
        if (pn < 8) {
            bf16_t* base = pn < 4 ? Q : K; const int colt = (pn & 3) * BM; const float sc = pn < 4 ? QSCALE : 1.f;
            const bool ropew = (wc & 1) == 0;
#pragma unroll
            for (int ai = 0; ai < 2; ++ai)
#pragma unroll
                for (int m = 0; m < 4; ++m) { const int row = row0 + ai * HALF + m * 16; const int pos = row < NPROMPT ? (row & 2047) : (row & 4095); const float rstd = rstd_of(SS[row]);
                    f32x4 c0 = {1.f, 1.f, 1.f, 1.f}, c1 = c0, s0 = {0.f, 0.f, 0.f, 0.f}, s1 = s0;
                    if (ropew) { c0 = *(const f32x4*)(rope + pos * 8); c1 = *(const f32x4*)(rope + pos * 8 + 4); s0 = *(const f32x4*)(rope + 32768 + pos * 8); s1 = *(const f32x4*)(rope + 32768 + pos * 8 + 4); }
#pragma unroll
                    for (int bj = 0; bj < 2; ++bj) { f32x4 v0 = acc[ai][bj][m][0], v1 = acc[ai][bj][m][1];
                        if (ropew) { f32x4 o0, o1;
#pragma unroll
                            for (int i = 0; i < 4; ++i) { o0[i] = get_xor16(v0[i], (fq & 1) != 0); o1[i] = get_xor16(v1[i], (fq & 1) != 0); }
                            if (fq == 0) { v0 = v0 * c0 - o0 * s0; v1 = v1 * c1 - o1 * s1; } else if (fq == 1) { v0 = v0 * c0 + o0 * s0; v1 = v1 * c1 + o1 * s1; } }
                        v0 = v0 * (sc * rstd); v1 = v1 * (sc * rstd);
                        *(u32x4*)(base + (size_t)row * 1024 + colt + bj * HALF + cw) = pack8(v0, v1); }
                    asm volatile("" ::: "memory"); }
        } else if (pn < 14) {
#pragma unroll
            for (int ai = 0; ai < 2; ++ai)
#pragma unroll
                for (int m = 0; m < 4; ++m) { const int row = row0 + ai * HALF + m * 16; const float rstd = rstd_of(SS[row]);
#pragma unroll
                    for (int bj = 0; bj < 2; ++bj) { const int cc = (pn - 12) * BM + bj * HALF + cw, g = cc >> 4, h0 = cc & 15;
                        *(u32x4*)(US + ((size_t)g * NTOK + row) * 16 + h0) = pack8(acc[ai][bj][m][0] * rstd, acc[ai][bj][m][1] * rstd); } }
        } else {
#pragma unroll
            for (int ai = 0; ai < 2; ++ai)
#pragma unroll
                for (int m = 0; m < 4; ++m) { const int row = row0 + ai * HALF + m * 16; const float rstd = rstd_of(SS[row]);
#pragma unroll
                    for (int bj = 0; bj < 2; ++bj) { const int cc = (pn - 14) * BM + bj * HALF + cw;
                        *(u32x4*)(UP + (size_t)row * 512 + cc) = pack8(acc[ai][bj][m][0] * rstd, acc[ai][bj][m][1] * rstd); } }
        }
    }
};
struct EpiSsm1 { static constexpr bool PERM = true, AFTER_DRAIN = false; static constexpr bool PERM2 = false; static constexpr int NVM = 16;
    bf16_t* YI; size_t zoff;
    __device__ __forceinline__ void operator()(const f32x4 (&acc)[2][2][4][2], const Unit& u, int wr, int wc, int fr, int fq) const {
        asm volatile("" : "+v"(fr), "+v"(fq));
        const int row0 = u.pm * BM + wr * 64 + fr, col0 = wc * 32 + 8 * fq; bf16_t* O = YI + (size_t)(u.pn & 1) * zoff;
#pragma unroll
        for (int ai = 0; ai < 2; ++ai)
#pragma unroll
            for (int m = 0; m < 4; ++m) { bf16_t* rp = O + (size_t)(row0 + ai * HALF + m * 16) * 256 + col0;
#pragma unroll
                for (int bj = 0; bj < 2; ++bj) *(u32x4*)(rp + bj * HALF) = pack8(acc[ai][bj][m][0], acc[ai][bj][m][1]); }
    }
};
__device__ __forceinline__ float gelu_tanh(float y) {
    const float u2 = 1.5957691216057308f * (y + 0.044715f * y * y * y);
    return y * __builtin_amdgcn_rcpf(1.f + __builtin_amdgcn_exp2f(-1.4426950408889634f * u2));
}
struct EpiSsm2 { static constexpr bool PERM = true, AFTER_DRAIN = false; static constexpr bool PERM2 = false; static constexpr int NVM = 32;
    const bf16_t* YI; bf16_t* ZB;
    __device__ __forceinline__ void operator()(const f32x4 (&acc)[2][2][4][2], const Unit& u, int wr, int wc, int fr, int fq) const {
        asm volatile("" : "+v"(fr), "+v"(fq));
        const int g = u.pn, row0 = u.pm * BM + wr * 64 + fr, col0 = wc * 32 + 8 * fq;
#pragma unroll
        for (int ai = 0; ai < 2; ++ai)
#pragma unroll
            for (int m = 0; m < 4; ++m) { const int row = row0 + ai * HALF + m * 16, chunk = row - g * NCHUNK;
#pragma unroll
                for (int bj = 0; bj < 2; ++bj) { const int col = col0 + bj * HALF; const u32x4 yi = *(const u32x4*)(YI + (size_t)row * 256 + col); const f32x4 a = acc[ai][bj][m][0], b = acc[ai][bj][m][1];
                    const f32x4 v = {gelu_tanh(a[0] + bf_lo(yi.x)), gelu_tanh(a[1] + bf_hi(yi.x)), gelu_tanh(a[2] + bf_lo(yi.y)), gelu_tanh(a[3] + bf_hi(yi.y))};
                    const f32x4 w = {gelu_tanh(b[0] + bf_lo(yi.z)), gelu_tanh(b[1] + bf_hi(yi.z)), gelu_tanh(b[2] + bf_lo(yi.w)), gelu_tanh(b[3] + bf_hi(yi.w))};
                    *(u32x4*)(ZB + (size_t)(chunk * CH_T + (col >> 4)) * 512 + g * 16 + (col & 15)) = pack8(v, w); }
                asm volatile("" ::: "memory"); }
    }
};
struct EpiGluPool { static constexpr bool PERM = true, AFTER_DRAIN = false; static constexpr bool PERM2 = false; static constexpr int NVM = 16;
    const bf16_t* ZB; const float* glu_b; bf16_t* MIX;
    __device__ __forceinline__ void operator()(const f32x4 (&acc)[2][2][4][2], const Unit& u, int wr, int wc, int fr, int fq) const {
        asm volatile("" : "+v"(fr), "+v"(fq));
        const bool glu = u.pn < 2; const int pm = glu ? u.pm : u.pm - 192, pn = glu ? u.pn : u.pn - 2;
        const int row0 = pm * BM + wr * 64 + fr, col0 = pn * BM + wc * 32 + 8 * fq;
#pragma unroll
        for (int ai = 0; ai < 2; ++ai)
#pragma unroll
            for (int m = 0; m < 4; ++m) { const int row = row0 + ai * HALF + m * 16;
#pragma unroll
                for (int bj = 0; bj < 2; ++bj) { const int col = col0 + bj * HALF; f32x4 v0 = acc[ai][bj][m][0], v1 = acc[ai][bj][m][1];
                    if (glu) { const u32x4 zz = *(const u32x4*)(ZB + (size_t)row * 512 + col); const f32x4 b0 = *(const f32x4*)(glu_b + col), b1 = *(const f32x4*)(glu_b + col + 4);
                        const float z[8] = {bf_lo(zz.x), bf_hi(zz.x), bf_lo(zz.y), bf_hi(zz.y), bf_lo(zz.z), bf_hi(zz.z), bf_lo(zz.w), bf_hi(zz.w)};
#pragma unroll
                        for (int i = 0; i < 4; ++i) { v0[i] = z[i] * __builtin_amdgcn_rcpf(1.f + __builtin_amdgcn_exp2f(-1.4426950408889634f * (v0[i] + b0[i])));
                                                      v1[i] = z[4 + i] * __builtin_amdgcn_rcpf(1.f + __builtin_amdgcn_exp2f(-1.4426950408889634f * (v1[i] + b1[i]))); } }
                    *(u32x4*)(MIX + (size_t)row * DM + (glu ? 1024 : 1536) + col) = pack8(v0, v1); } }
    }
};
struct EpiResidX { static constexpr bool PERM = true, AFTER_DRAIN = false; static constexpr bool PERM2 = false; static constexpr int NVM = 32;
    const bf16_t* XI; bf16_t* XO; unsigned long long* SS; int row_off;
    __device__ __forceinline__ void operator()(const f32x4 (&acc)[2][2][4][2], const Unit& u, int wr, int wc, int fr, int fq) const {
        asm volatile("" : "+v"(fr), "+v"(fq));
        const int row0 = u.pm * BM + wr * 64 + fr + row_off, col0 = u.pn * BM + wc * 32 + 8 * fq;
#pragma unroll
        for (int ai = 0; ai < 2; ++ai) {
            u32x4 bv[4][2];
#pragma unroll
            for (int m = 0; m < 4; ++m) { const bf16_t* bp = XI + (size_t)(row0 + ai * HALF + m * 16) * DM + col0;
#pragma unroll
                for (int bj = 0; bj < 2; ++bj) bv[m][bj] = *(const u32x4*)(bp + bj * HALF); }
#pragma unroll
            for (int m = 0; m < 4; ++m) { const int row = row0 + ai * HALF + m * 16; bf16_t* xp = XO + (size_t)row * DM + col0;
                float s = 0.f;
#pragma unroll
                for (int bj = 0; bj < 2; ++bj) { const u32x4 x = bv[m][bj]; const f32x4 a = acc[ai][bj][m][0], b = acc[ai][bj][m][1];
                    const f32x4 v = {bf_lo(x.x) + a[0], bf_hi(x.x) + a[1], bf_lo(x.y) + a[2], bf_hi(x.y) + a[3]}, w = {bf_lo(x.z) + b[0], bf_hi(x.z) + b[1], bf_lo(x.w) + b[2], bf_hi(x.w) + b[3]};
                    s += ((v[0] * v[0] + v[1] * v[1]) + (v[2] * v[2] + v[3] * v[3])) + ((w[0] * w[0] + w[1] * w[1]) + (w[2] * w[2] + w[3] * w[3]));
                    *(u32x4*)(xp + bj * HALF) = pack8(v, w); }
                s = sum_xor32(sum_xor16(s));
                if (fq == 0) __hip_atomic_fetch_add(SS + row, (unsigned long long)(s * 1048576.f + 0.5f), __ATOMIC_RELAXED, __HIP_MEMORY_SCOPE_AGENT); }
            asm volatile("" ::: "memory");
        }
    }
};
struct EpiSqRelu { static constexpr bool PERM = true, AFTER_DRAIN = false; static constexpr bool PERM2 = true; static constexpr int NVM = 16;
    bf16_t* HID; int row_off; const unsigned long long* SS;
    __device__ __forceinline__ void operator()(const f32x4 (&acc)[2][2][4][2], const Unit& u, int wr, int wc, int fr, int fq) const {
        asm volatile("" : "+v"(fr), "+v"(fq));
        const int rown = u.pm * BM + wr * 64 + fr;
        bf16_t* base = HID + (size_t)(u.pm * BM + wr * 64 + (fr & 7) - row_off) * DFF + u.pn * BM + wc * 64 + 32 * (fr >> 3) + 8 * fq;
#pragma unroll
        for (int ai = 0; ai < 2; ++ai)
#pragma unroll
            for (int m = 0; m < 4; ++m) { const float rstd = rstd_of(SS[rown + ai * HALF + m * 16]);
                u32x4 d[2];
#pragma unroll
                for (int bj = 0; bj < 2; ++bj) { f32x4 v0 = acc[ai][bj][m][0], v1 = acc[ai][bj][m][1];
#pragma unroll
                    for (int i = 0; i < 4; ++i) { const float a = fmaxf(v0[i], 0.f) * rstd, b = fmaxf(v1[i], 0.f) * rstd; v0[i] = a * a; v1[i] = b * b; }
                    d[bj] = pack8(v0, v1); }
                u32x4 x, y;
#pragma unroll
                for (int i = 0; i < 4; ++i) { x[i] = (unsigned)__builtin_amdgcn_update_dpp((int)d[0][i], (int)d[1][i], 0x128, 0xF, 0xC, false);
                                              y[i] = (unsigned)__builtin_amdgcn_update_dpp((int)d[1][i], (int)d[0][i], 0x128, 0xF, 0x3, false); }
                bf16_t* p = base + (size_t)(ai * HALF + m * 16) * DFF;
                *(u32x4*)p = x; *(u32x4*)(p + (size_t)8 * DFF) = y; }
    }
};

#ifdef PROBE_EPI2
template <class E> struct Probe2 { static constexpr bool v = false; };
#if PROBE_EPI2 == 1
template <> struct Probe2<EpiInProj> { static constexpr bool v = true; };
template <> struct Probe2<EpiVT> { static constexpr bool v = true; };
#else
template <> struct Probe2<EpiSqRelu> { static constexpr bool v = true; };
#endif
#endif
template <class Epi, class Sched, bool ALIGN_EPI = false, bool SP2 = false>
__device__ __forceinline__ void gemm_phase(PG8_LAS unsigned char* lds, const Gemm g, const Sched& S, const Epi& E, int tid_) {
    asm volatile("" : "+v"(tid_));
    const int tid = tid_, wid = __builtin_amdgcn_readfirstlane(tid >> 6), lane = tid & 63, wr = wid >> 2, wc = wid & 3, fr = lane & 15, fq = lane >> 4;
    const int K = g.K, nt = K / BK;
    unsigned voffA[2], voffB[2];
#pragma unroll
    for (int i = 0; i < 2; ++i) { int R, C; stage_rc(tid * 16 + i * 8192, R, C); const int Rb = Epi::PERM2 ? ((R >> 5) * 64 + perm32(R & 31)) : Epi::PERM ? ((R & ~31) + perm32(R & 31)) : R;
        voffA[i] = (unsigned)(R * K + C) * 2u; voffB[i] = (unsigned)(Rb * K + C) * 2u; }
    const size_t kstep = (size_t)(BK * 2);
    const size_t hstep = (size_t)HALF * K * 2;
    const size_t hstepB = Epi::PERM2 ? (size_t)32 * K * 2 : hstep;
    const size_t tstep = 2 * hstep;
    const unsigned ldsw = (unsigned)wid * 1024u;
    const int aoff = lds_byte(wr * 64 + fr, fq * 8), boff = lds_byte(wc * 32 + fr, fq * 8);
#define PG8_SA(b, h) (((b) * 2 + (h)) * HTB)
#define PG8_SB(b, h) ((4 + (b) * 2 + (h)) * HTB)
    const unsigned lds_u32 = (unsigned)(uintptr_t)lds + ldsw;
#define PG8_STAGE(bufoff, gbase, voff) do { _Pragma("unroll") for (int _i = 0; _i < 2; ++_i) \
        glds_saddr((const char*)(gbase), (voff)[_i], lds_u32 + (unsigned)((bufoff) + _i * 8192)); } while (0)
#define PG8_LDA(dst, b, h) do { _Pragma("unroll") for (int m = 0; m < 4; ++m) _Pragma("unroll") for (int k = 0; k < 2; ++k) dst[m][k] = *(const PG8_LAS bf16x8*)(lds + PG8_SA(b, h) + aoff + m * 2048 + k * 1024); } while (0)
#define PG8_LDB(dst, b, h) do { _Pragma("unroll") for (int n = 0; n < 2; ++n) _Pragma("unroll") for (int k = 0; k < 2; ++k) dst[n][k] = *(const PG8_LAS bf16x8*)(lds + PG8_SB(b, h) + boff + n * 2048 + k * 1024); } while (0)
#define PG8_MMA(ai, bj, At, Bt) do { __builtin_amdgcn_s_setprio(1); _Pragma("unroll") for (int m = 0; m < 4; ++m) _Pragma("unroll") for (int n = 0; n < 2; ++n) _Pragma("unroll") for (int k = 0; k < 2; ++k) \
        acc[ai][bj][m][n] = __builtin_amdgcn_mfma_f32_16x16x32_bf16(Bt[n][k], At[m][k], acc[ai][bj][m][n], 0, 0, 0); __builtin_amdgcn_s_setprio(0); } while (0)
#define PG8_WAIT_V(n) asm volatile("s_waitcnt vmcnt(" #n ")" ::: "memory")
#define PG8_WAIT_L(n) asm volatile("s_waitcnt lgkmcnt(" #n ")" ::: "memory")
#define PG8_WAIT_VR(rx) do { if (rx) asm volatile("s_waitcnt vmcnt(%0)" :: "n"(8 + Epi::NVM) : "memory"); else PG8_WAIT_V(8); } while (0)
#define PG8_BAR __builtin_amdgcn_s_barrier()
#define PG8_SCHED __builtin_amdgcn_sched_barrier(0)
    Unit cur, nxt; int ui = 0;
    if (!S.next(0, cur)) return;
    f32x4 acc[2][2][4][2];
#pragma unroll
    for (int a = 0; a < 2; ++a)
#pragma unroll
        for (int b = 0; b < 2; ++b)
#pragma unroll
            for (int m = 0; m < 4; ++m)
#pragma unroll
                for (int n = 0; n < 2; ++n) acc[a][b][m][n] = (f32x4){0.f, 0.f, 0.f, 0.f};
    bf16x8 At[4][2], B0[2][2], B1[2][2];
    const char* cA = (const char*)g.A + (size_t)cur.pm * tstep; const char* cB = (const char*)g.Bt + (size_t)cur.pn * tstep;
    S.a_ready(cur);
    if constexpr (SP2) {
        PG8_STAGE(PG8_SB(0, 0), cB, voffB); PG8_STAGE(PG8_SB(0, 1), cB + hstepB, voffB); PG8_STAGE(PG8_SA(0, 0), cA, voffA); PG8_STAGE(PG8_SA(0, 1), cA + hstep, voffA);
        if (wr == 1) PG8_BAR;
        PG8_WAIT_V(2); PG8_BAR;
        PG8_STAGE(PG8_SB(1, 0), cB + kstep, voffB); PG8_STAGE(PG8_SA(1, 0), cA + kstep, voffA); PG8_STAGE(PG8_SB(1, 1), cB + hstepB + kstep, voffB);
        PG8_WAIT_V(0); PG8_BAR;
    } else {
        PG8_STAGE(PG8_SB(0, 0), cB, voffB); PG8_STAGE(PG8_SA(0, 0), cA, voffA); PG8_STAGE(PG8_SB(0, 1), cB + hstepB, voffB); PG8_STAGE(PG8_SA(0, 1), cA + hstep, voffA);
        if (wr == 1) PG8_BAR;
        PG8_WAIT_V(4); PG8_BAR;
        PG8_STAGE(PG8_SB(1, 0), cB + kstep, voffB); PG8_STAGE(PG8_SA(1, 0), cA + kstep, voffA); PG8_STAGE(PG8_SB(1, 1), cB + hstepB + kstep, voffB);
        PG8_WAIT_V(6); PG8_BAR;
    }
    for (;;) {
        const bool has_next = S.next(ui + 1, nxt);
        const char* nA = has_next ? (const char*)g.A + (size_t)nxt.pm * tstep : cA; const char* nB = has_next ? (const char*)g.Bt + (size_t)nxt.pn * tstep : cB;
        for (int t = 0; t < nt; t += 2) {
            const bool last = (t == nt - 2);
            const bool relax = SP2 && (t == 0);
            const char* a1 = cA + (size_t)(t + 1) * kstep;
            const char* a2 = last ? nA : cA + (size_t)(t + 2) * kstep; const char* b2 = last ? nB : cB + (size_t)(t + 2) * kstep;
            const char* a3 = a2 + kstep; const char* b3 = b2 + kstep;
            if (last && has_next) S.a_ready(nxt);
            if constexpr (SP2) {
            PG8_LDB(B0, 0, 0); PG8_LDB(B1, 0, 1); PG8_SCHED; PG8_LDA(At, 0, 0); PG8_STAGE(PG8_SA(1, 1), a1 + hstep, voffA);
            PG8_WAIT_VR(relax); PG8_WAIT_L(0); PG8_BAR; PG8_MMA(0, 0, At, B0); PG8_MMA(0, 1, At, B1); PG8_BAR; PG8_SCHED;
            PG8_LDA(At, 0, 1); PG8_STAGE(PG8_SB(0, 0), b2, voffB); PG8_STAGE(PG8_SB(0, 1), b2 + hstepB, voffB); PG8_STAGE(PG8_SA(0, 0), a2, voffA);
            PG8_WAIT_VR(relax); PG8_WAIT_L(0); PG8_BAR; PG8_MMA(1, 0, At, B0); PG8_MMA(1, 1, At, B1); PG8_BAR; PG8_SCHED;
            PG8_LDB(B0, 1, 0); PG8_LDB(B1, 1, 1); PG8_SCHED; PG8_LDA(At, 1, 0); PG8_STAGE(PG8_SA(0, 1), a2 + hstep, voffA);
            PG8_WAIT_V(8); PG8_WAIT_L(0); PG8_BAR; PG8_MMA(0, 0, At, B0); PG8_MMA(0, 1, At, B1); PG8_BAR; PG8_SCHED;
            PG8_LDA(At, 1, 1); PG8_STAGE(PG8_SB(1, 0), b3, voffB); PG8_STAGE(PG8_SB(1, 1), b3 + hstepB, voffB); PG8_STAGE(PG8_SA(1, 0), a3, voffA);
            PG8_WAIT_V(8); PG8_WAIT_L(0); PG8_BAR; PG8_MMA(1, 0, At, B0); PG8_MMA(1, 1, At, B1); PG8_BAR; PG8_SCHED;
            } else {
            PG8_LDB(B0, 0, 0); PG8_SCHED; PG8_LDA(At, 0, 0); PG8_STAGE(PG8_SA(1, 1), a1 + hstep, voffA);
            PG8_WAIT_L(8); PG8_BAR; PG8_WAIT_L(0); PG8_MMA(0, 0, At, B0); PG8_BAR; PG8_SCHED;
            PG8_LDB(B1, 0, 1); PG8_STAGE(PG8_SB(0, 0), b2, voffB);
            PG8_BAR; PG8_WAIT_L(0); PG8_MMA(0, 1, At, B1); PG8_BAR;
            PG8_LDA(At, 0, 1); PG8_STAGE(PG8_SA(0, 0), a2, voffA);
            PG8_BAR; PG8_WAIT_L(0); PG8_MMA(1, 0, At, B0); PG8_BAR; PG8_SCHED;
            PG8_STAGE(PG8_SB(0, 1), b2 + hstepB, voffB);
            PG8_WAIT_V(6); PG8_BAR; PG8_MMA(1, 1, At, B1); PG8_BAR;
            PG8_LDB(B0, 1, 0); PG8_SCHED; PG8_LDA(At, 1, 0); PG8_STAGE(PG8_SA(0, 1), a2 + hstep, voffA);
            PG8_WAIT_L(8); PG8_BAR; PG8_WAIT_L(0); PG8_MMA(0, 0, At, B0); PG8_BAR; PG8_SCHED;
            PG8_LDB(B1, 1, 1); PG8_STAGE(PG8_SB(1, 0), b3, voffB);
            PG8_BAR; PG8_WAIT_L(0); PG8_MMA(0, 1, At, B1); PG8_BAR;
            PG8_LDA(At, 1, 1); PG8_STAGE(PG8_SA(1, 0), a3, voffA);
            PG8_BAR; PG8_WAIT_L(0); PG8_MMA(1, 0, At, B0); PG8_BAR; PG8_SCHED;
            PG8_STAGE(PG8_SB(1, 1), b3 + hstepB, voffB);
            PG8_WAIT_V(6); PG8_BAR; PG8_MMA(1, 1, At, B1); PG8_BAR;
            }
        }
        if constexpr (ALIGN_EPI) { if (wr == 0) PG8_BAR; }
        if constexpr (!Epi::AFTER_DRAIN) { E(acc, cur, wr, wc, fr, fq);
#ifdef PROBE_EPI2
            if constexpr (Probe2<Epi>::v) { asm volatile("" ::: "memory"); E(acc, cur, wr, wc, fr, fq); }
#endif
            S.done(cur); }
        if (!has_next) break;
#pragma unroll
        for (int a = 0; a < 2; ++a)
#pragma unroll
            for (int b = 0; b < 2; ++b)
#pragma unroll
                for (int m = 0; m < 4; ++m)
#pragma unroll
                    for (int n = 0; n < 2; ++n) acc[a][b][m][n] = (f32x4){0.f, 0.f, 0.f, 0.f};
        cur = nxt; cA = nA; cB = nB; ++ui;
        if constexpr (ALIGN_EPI) { if (wr == 1) PG8_BAR; }
    }
    PG8_WAIT_V(0);
    if constexpr (!ALIGN_EPI) { if (wr == 0) PG8_BAR; }
    PG8_BAR;
    if constexpr (Epi::AFTER_DRAIN) { E.fused(acc, cur, wr, wc, fr, fq, lds, wid, lane); S.done(cur); }
#undef PG8_SA
#undef PG8_SB
#undef PG8_STAGE
#undef PG8_LDA
#undef PG8_LDB
#undef PG8_MMA
#undef PG8_WAIT_V
#undef PG8_WAIT_L
#undef PG8_WAIT_VR
#undef PG8_BAR
#undef PG8_SCHED
}
}
constexpr int NWAVES = 8;
constexpr size_t MiB = 1u << 20;
constexpr size_t WS_CTL = 0, CTL_ZERO_BYTES = 1 * MiB;
constexpr size_t WS_SS = 4 * MiB, SS_BYTES = 4 * MiB;
constexpr size_t WS_ROPE = 1 * MiB;
constexpr size_t WS_AT = 2 * MiB;
constexpr size_t WS_WIN = 16 * MiB, WS_WOUT = 32 * MiB, WS_WUP = 40 * MiB, WS_WDN = 72 * MiB;
constexpr size_t WS_SSM1 = 104 * MiB, WS_SSM2 = 112 * MiB, WS_GP = 116 * MiB;
constexpr size_t WS_HB = 120 * MiB;
constexpr size_t WS_Q = 312 * MiB, WS_K = 408 * MiB, WS_VT = 504 * MiB, WS_US = 600 * MiB, WS_UP = 648 * MiB;
constexpr size_t WS_YI = 696 * MiB, WS_Z = 744 * MiB, WS_SP = 840 * MiB, WS_ZB = 888 * MiB, WS_PL = 936 * MiB;
constexpr size_t WS_HID = 312 * MiB;
constexpr size_t WS_END = 984 * MiB;
static_assert(WS_PL == WS_ZB + (size_t)NTOK * 512 * 2 && WS_HID + (size_t)8192 * DFF * 2 <= WS_YI, "ws map");
constexpr int CW_BAR = 4096;
constexpr int RING_BYTES = 131072, LDSCTL_OFF = RING_BYTES, MISC_OFF = LDSCTL_OFF + 320, LDS_BYTES = 147456;

#define GAS __attribute__((address_space(1)))
#define LAS __attribute__((address_space(3)))
typedef unsigned short bf16;
typedef unsigned v4u __attribute__((ext_vector_type(4)));
typedef unsigned v2u __attribute__((ext_vector_type(2)));
typedef float f32x4 __attribute__((ext_vector_type(4)));
typedef float f32x16 __attribute__((ext_vector_type(16)));
typedef short bf16x8 __attribute__((ext_vector_type(8)));
typedef GAS unsigned gu32;
#define LDS_WAIT() asm volatile("s_waitcnt lgkmcnt(0)" ::: "memory")
#define VM_WAIT() asm volatile("s_waitcnt vmcnt(0)" ::: "memory")
using pg8::cvt_pk_bf16; using pg8::bf_lo; using pg8::bf_hi;

#define XB_TMO      128
#define XB_XCNT(j)  (256  + 64 * (j))
#define XB_XSUB(j)  (1280 + 64 * (j))
#define XB_XGEN(j)  (2304 + 64 * (j))
#define XB_TOP      3328
#define XB_TOPGEN   3392
#define XCD_BAR_WORDS 3456
#define XB_SPIN_CAP (1u << 18)

__device__ __forceinline__ unsigned xb_ld(unsigned* p)              { return __hip_atomic_load(p, __ATOMIC_RELAXED, __HIP_MEMORY_SCOPE_AGENT); }
__device__ __forceinline__ unsigned xb_add(unsigned* p, unsigned v) { return __hip_atomic_fetch_add(p, v, __ATOMIC_RELAXED, __HIP_MEMORY_SCOPE_AGENT); }
__device__ __forceinline__ unsigned xb_xcc_id() { return (unsigned)__builtin_amdgcn_s_getreg((3 << 11) | 20) & 0xFu; }
#define XB_SPIN(cond, bar) do { unsigned _sp = 0; while (cond) { __builtin_amdgcn_s_sleep(1); \
    if ((++_sp & 255u) == 0u) { if (xb_ld(&(bar)[XB_TMO])) break; if (_sp > XB_SPIN_CAP) { atomicAdd(&(bar)[XB_TMO], 1u); break; } } } } while (0)

struct XcdBarrier {
    unsigned* bar; unsigned x;
    volatile LAS unsigned* st;
};

__device__ __forceinline__ XcdBarrier xcd_barrier_post(unsigned* bar, volatile LAS unsigned* st) {
    XcdBarrier b; b.bar = bar; b.x = xb_xcc_id(); b.st = st;
    if (threadIdx.x == 0) (void)xb_add(&bar[XB_XCNT(b.x)], 1u);
    return b;
}
__device__ __forceinline__ void xcd_barrier_complete(unsigned* bar, unsigned x, unsigned& nloc, unsigned& nx) {
    const unsigned G = gridDim.x * gridDim.y * gridDim.z;
    unsigned sum, cnt, mine, sp = 0u;
    for (;;) {
        sum = 0u; cnt = 0u; mine = 0u;
#pragma unroll
        for (unsigned j = 0; j < 16; ++j) { const unsigned c = xb_ld(&bar[XB_XCNT(j)]); sum += c; cnt += (c > 0u) ? 1u : 0u; mine = (j == x) ? c : mine; }
        if (sum == G) break;
        __builtin_amdgcn_s_sleep(1);
        if ((++sp & 255u) == 0u) { if (xb_ld(&bar[XB_TMO])) break; if (sp > XB_SPIN_CAP) { atomicAdd(&bar[XB_TMO], 1u); break; } }
    }
    nloc = mine > 0u ? mine : 1u; nx = cnt > 0u ? cnt : 1u;
}

__device__ __forceinline__ void xcd_barrier(const XcdBarrier& b) {
    asm volatile("s_waitcnt vmcnt(0)" ::: "memory");
    __syncthreads();
    if (threadIdx.x == 0) {
        unsigned* bar = b.bar;
        __builtin_amdgcn_s_waitcnt(0);
        unsigned nloc = b.st[0], nx = b.st[1];
        if (nloc == 0u) { xcd_barrier_complete(bar, b.x, nloc, nx); b.st[0] = nloc; b.st[1] = nx; }
        const unsigned old = xb_add(&bar[XB_XSUB(b.x)], 1u);
        const unsigned gen = old / nloc;
        if (old + 1u == (gen + 1u) * nloc) {
            __builtin_amdgcn_fence(__ATOMIC_RELEASE, "agent");
            asm volatile("s_waitcnt vmcnt(0)" ::: "memory");
            const unsigned og = xb_add(&bar[XB_TOP], 1u);
            const unsigned tg = og / nx;
            if (og + 1u == (tg + 1u) * nx) xb_add(&bar[XB_TOPGEN], 1u);
            else XB_SPIN(xb_ld(&bar[XB_TOPGEN]) == tg, bar);
            __builtin_amdgcn_fence(__ATOMIC_ACQUIRE, "agent");
            xb_add(&bar[XB_XGEN(b.x)], 1u);
            asm volatile("s_waitcnt vmcnt(0)" ::: "memory");
        } else {
            XB_SPIN(xb_ld(&bar[XB_XGEN(b.x)]) == gen, bar);
            __builtin_amdgcn_fence(__ATOMIC_ACQUIRE, "agent");
            asm volatile("s_waitcnt vmcnt(0)" ::: "memory");
        }
    }
    __syncthreads();
}
struct Frame {
    LAS unsigned char* lds;
    int tid, lane, wave, vcu, G;
    float* out; unsigned char* ws;
};
__device__ __forceinline__ float wave_sum(float v, int lane) {
#pragma unroll
    for (int o = 1; o < 16; o <<= 1) v += __uint_as_float((unsigned)__builtin_amdgcn_ds_bpermute((lane ^ o) << 2, (int)__float_as_uint(v)));
    return pg8::sum_xor32(pg8::sum_xor16(v));
}
__device__ __forceinline__ void transpose_item(const float* W, int K, int N, bf16* WT, LAS float* scr, int item, int lane, const float* gain = nullptr) {
    const int nblk = N / 32, kb = item / nblk, nb = item % nblk, k0 = 64 * kb, n0 = 32 * nb;
#pragma unroll 8
    for (int i = 0; i < 32; ++i) { const int kk = 2 * i + (lane >> 5); scr[kk * 33 + (lane & 31)] = W[(size_t)(k0 + kk) * N + n0 + (lane & 31)] * (gain ? gain[k0 + kk] : 1.f); }
    LDS_WAIT(); asm volatile("" ::: "memory");
    const int c = lane & 7;
#pragma unroll
    for (int j = 0; j < 4; ++j) { const int n = (lane >> 3) + 8 * j; const LAS float* s = scr + (8 * c) * 33 + n;
        v4u o; o.x = cvt_pk_bf16(s[0 * 33], s[1 * 33]); o.y = cvt_pk_bf16(s[2 * 33], s[3 * 33]); o.z = cvt_pk_bf16(s[4 * 33], s[5 * 33]); o.w = cvt_pk_bf16(s[6 * 33], s[7 * 33]);
        *(v4u*)(WT + (size_t)(n0 + n) * K + k0 + 8 * c) = o; }
    LDS_WAIT(); asm volatile("" ::: "memory");
}
struct WPtrs { const float *w_in, *w_out, *glu_w, *pool_w, *pool_s, *w_up, *w_dn, *g_mix, *g_mlp; };
__device__ __forceinline__ void convert_weights(Frame& F, const WPtrs& W, int l, int what, int cu_idx, int cu_cnt) {
    LAS float* scr = (LAS float*)(F.lds + F.wave * 16384);
    const int gw = cu_idx * NWAVES + F.wave, NGW = cu_cnt * NWAVES;
    bf16* Win_t = (bf16*)(F.ws + WS_WIN); bf16* Wout_t = (bf16*)(F.ws + WS_WOUT); bf16* Wup_t = (bf16*)(F.ws + WS_WUP); bf16* Wdn_t = (bf16*)(F.ws + WS_WDN); bf16* GP = (bf16*)(F.ws + WS_GP);
    if (what & 1) {
        const float* w_in = W.w_in + (size_t)l * DM * 4096; const float* w_out = W.w_out + (size_t)l * DM * DM; const float* glu_w = W.glu_w + (size_t)l * 512 * 512;
        constexpr int I_IN = (DM / 64) * (4096 / 32), I_OUT = (DM / 64) * (DM / 32), I_GLU = (512 / 64) * (512 / 32);
        for (int it = gw; it < I_IN + I_OUT + I_GLU; it += NGW) {
            int r = it;
            if (r < I_IN) { transpose_item(w_in, DM, 4096, Win_t, scr, r, F.lane, W.g_mix + (size_t)l * DM); continue; } r -= I_IN;
            if (r < I_OUT) { transpose_item(w_out, DM, DM, Wout_t, scr, r, F.lane); continue; } r -= I_OUT;
            transpose_item(glu_w, 512, 512, GP, scr, r, F.lane);
        }
        const float* pool_w = W.pool_w + (size_t)l * 4 * 128 * 128; const float* pool_s = W.pool_s + (size_t)l * 512;
        for (int e = (cu_idx * 512 + F.tid); e < 512 * 512; e += cu_cnt * 512) { const int n = e >> 9, k = e & 511, gi = n >> 7, gj = k >> 7;
            const float v = (gi == gj) ? pool_w[((size_t)gi * 128 + (k & 127)) * 128 + (n & 127)] * pool_s[n] : 0.f;
            GP[(size_t)(512 + n) * 512 + k] = (bf16)(cvt_pk_bf16(v, 0.f) & 0xffffu); }
    }
    if (what & 2) {
        const float* w_up = W.w_up + (size_t)l * DM * DFF; const float* w_dn = W.w_dn + (size_t)l * DFF * DM;
        constexpr int I_UP = (DM / 64) * (DFF / 32), I_DN = (DFF / 64) * (DM / 32);
        for (int it = gw; it < I_UP + I_DN; it += NGW) {
            if (it < I_UP) transpose_item(w_up, DM, DFF, Wup_t, scr, it, F.lane, W.g_mlp + (size_t)l * DM); else transpose_item(w_dn, DFF, DM, Wdn_t, scr, it - I_UP, F.lane);
        }
    }
    if (what & 4) {
        float* rope = (float*)(F.ws + WS_ROPE);
        for (int e = cu_idx * 512 + F.tid; e < 4096 * 8; e += cu_cnt * 512) { const int pos = e >> 3, j = e & 7;
            const float inv = powf(500000.0f, -(float)(2 * j) / 16.0f); const float ang = (float)pos * inv; float s, c; sincosf(ang, &s, &c);
            rope[e] = c; rope[32768 + e] = s; }
    }
}
struct SPtrs { const float *lam_re, *lam_im, *log_dt, *b_re, *b_im, *c_re, *c_im, *d; };
constexpr int SSM_SPLIT = 4;
__device__ __forceinline__ void ssm_weights(Frame& F, const SPtrs& S, int l) {
    typedef float f2 __attribute__((ext_vector_type(2)));
    LAS f2* AP = (LAS f2*)F.lds;
    LAS f2* BB = AP + 2 * 64 * 17;
    LAS f2* CC = BB + 2 * 64 * 16;
    LAS float* KT = (LAS float*)(CC + 2 * 16 * 64);
    const float* lam_re = S.lam_re; const float* lam_im = S.lam_im; const float* log_dt = S.log_dt;
    const float* b_re = S.b_re; const float* b_im = S.b_im; const float* c_re = S.c_re; const float* c_im = S.c_im; const float* dskip = S.d + (size_t)l * 512;
    bf16* W1 = (bf16*)(F.ws + WS_SSM1); bf16* W2 = (bf16*)(F.ws + WS_SSM2); float* AT = (float*)(F.ws + WS_AT);
    for (int task = blockIdx.x; task < NGRP * SSM_SPLIT; task += F.G) { const int g = task / SSM_SPLIT, sq = task % SSM_SPLIT;
        __syncthreads();
        if (F.tid < 128) { const int dir = F.tid >> 6, p = F.tid & 63; const int idx = (l * 2 + dir) * NGRP + g;
            const float lr = lam_re[(size_t)idx * 64 + p], li = lam_im[(size_t)idx * 64 + p], dt = expf(log_dt[idx]);
            for (int k = 0; k <= 16; ++k) { const float mag = expf(lr * dt * (float)k); float s, c; sincosf(li * dt * (float)k, &s, &c); AP[(dir * 64 + p) * 17 + k] = (f2){mag * c, mag * s}; }
            float s1, c1; sincosf(li * dt, &s1, &c1); const float mag1 = expf(lr * dt), ai = mag1 * s1; const float sh = sinf(0.5f * li * dt);
            const float nr = expm1f(lr * dt) * c1 - 2.f * sh * sh;
            const float den = lr * lr + li * li, cr = (nr * lr + ai * li) / den, ci = (ai * lr - nr * li) / den;
            for (int h = 0; h < 16; ++h) { const float br = b_re[((size_t)idx * 64 + p) * 16 + h], bi = b_im[((size_t)idx * 64 + p) * 16 + h]; BB[(dir * 64 + p) * 16 + h] = (f2){cr * br - ci * bi, cr * bi + ci * br}; }
            if (sq == 0) { const f2 a16 = AP[(dir * 64 + p) * 17 + 16]; AT[((dir * NGRP + g) * 64 + p) * 2] = a16.x; AT[((dir * NGRP + g) * 64 + p) * 2 + 1] = a16.y; }
        }
        for (int e = F.tid; e < 2 * 16 * 64; e += 512) { const int dir = e >> 10, h = (e >> 6) & 15, p = e & 63; const size_t gi = (((size_t)(l * 2 + dir) * NGRP + g) * 16 + h) * 64 + p; CC[e] = (f2){c_re[gi], c_im[gi]}; }
        __syncthreads();
        for (int e_ = F.tid; e_ < 8192 / SSM_SPLIT; e_ += 512) { const int dir = e_ >> 10, k = (e_ >> 6) & 15, h = 4 * sq + ((e_ >> 4) & 3), hp = e_ & 15, e = ((dir * 16 + k) * 16 + h) * 16 + hp; float acc = 0.f;
            for (int p = 0; p < 64; ++p) { const f2 c = CC[(dir * 16 + h) * 64 + p], a = AP[(dir * 64 + p) * 17 + k], b = BB[(dir * 64 + p) * 16 + hp];
                const float wr = c.x * a.x - c.y * a.y, wi = c.x * a.y + c.y * a.x; acc += wr * b.x - wi * b.y; }
            KT[e] = acc; }
        __syncthreads();
        for (int e = F.tid; e < 128 * 256; e += 512) { const int r = e >> 8, n = r < 64 ? (r >> 2) * 16 + 4 * sq + (r & 3) : 256 + 64 * sq + (r - 64), kk = e & 255, j = kk >> 4, hp = kk & 15; float v;
            if (n < 256) { const int i = n >> 4, h = n & 15; v = 0.f;
                if (j <= i) v += KT[((0 * 16 + (i - j)) * 16 + h) * 16 + hp];
                if (j >= i) v += KT[((1 * 16 + (j - i)) * 16 + h) * 16 + hp];
                if (i == j && h == hp) v += dskip[g * 16 + h];
            } else { const int q = n - 256, dir = q >> 7, p = q & 63, im = (q >> 6) & 1, ex = dir == 0 ? 15 - j : j; const f2 a = AP[(dir * 64 + p) * 17 + ex], b = BB[(dir * 64 + p) * 16 + hp];
                v = im ? a.x * b.y + a.y * b.x : a.x * b.x - a.y * b.y; }
            W1[((size_t)g * 512 + n) * 256 + kk] = (bf16)(cvt_pk_bf16(v, 0.f) & 0xffffu); }
        for (int e = F.tid; e < 64 * 256; e += 512) { const int r = e >> 8, n = (r >> 2) * 16 + 4 * sq + (r & 3), kk = e & 255, i = n >> 4, h = n & 15, dir = kk >> 7, p = kk & 63, im = (kk >> 6) & 1, ex = dir == 0 ? i + 1 : 16 - i;
            const f2 c = CC[(dir * 16 + h) * 64 + p], a = AP[(dir * 64 + p) * 17 + ex]; const float wr = c.x * a.x - c.y * a.y, wi = c.x * a.y + c.y * a.x;
            W2[((size_t)g * 256 + n) * 256 + kk] = (bf16)(cvt_pk_bf16(im ? -wi : wr, 0.f) & 0xffffu); }
    }
    __syncthreads();
}
__device__ __forceinline__ void input_rows(Frame& F, const float* x0, const float* x1, bf16* o, unsigned long long* SS) {
    const int gw = F.vcu * NWAVES + F.wave, NGW = F.G * NWAVES;
    for (int row = gw; row < NTOK; row += NGW) {
        const float* xr = row < NPROMPT ? x0 + (size_t)row * DM : x1 + (size_t)(row - NPROMPT) * DM;
        f32x4 v[8]; float s = 0.f;
#pragma unroll
        for (int j = 0; j < 8; ++j) { v[j] = ((const f32x4*)xr)[F.lane + 64 * j]; s += (v[j].x * v[j].x + v[j].y * v[j].y) + (v[j].z * v[j].z + v[j].w * v[j].w); }
        s = wave_sum(s, F.lane); if (F.lane == 0) SS[row] = (unsigned long long)(s * 1048576.f + 0.5f);
#pragma unroll
        for (int j = 0; j < 8; ++j) { v2u w; w.x = cvt_pk_bf16(v[j].x, v[j].y); w.y = cvt_pk_bf16(v[j].z, v[j].w); ((v2u*)(o + (size_t)row * DM))[F.lane + 64 * j] = w; }
    }
}
__device__ __forceinline__ void final_norm(Frame& F, const bf16* X, const float* g, const unsigned long long* SS) {
    const int gw = F.vcu * NWAVES + F.wave, NGW = F.G * NWAVES;
    for (int row = gw; row < NTOK; row += NGW) {
        const v2u* xr = (const v2u*)(X + (size_t)row * DM); f32x4* orow = (f32x4*)(F.out + (size_t)row * DM);
        const float rstd = pg8::rstd_of(SS[row]);
#pragma unroll
        for (int j = 0; j < 8; ++j) { const v2u x = xr[F.lane + 64 * j]; const f32x4 gg = ((const f32x4*)g)[F.lane + 64 * j];
            f32x4 o; o.x = bf_lo(x.x) * rstd * gg.x; o.y = bf_hi(x.x) * rstd * gg.y; o.z = bf_lo(x.y) * rstd * gg.z; o.w = bf_hi(x.y) * rstd * gg.w;
            orow[F.lane + 64 * j] = o; }
    }
}
__device__ __forceinline__ void pool_prepass(Frame& F) {
    const bf16* __restrict__ UP = (const bf16*)(F.ws + WS_UP); bf16* __restrict__ PL = (bf16*)(F.ws + WS_PL);
    const int ws_ = (F.G >= 256) ? 5 : 0, nw_ = NWAVES - ws_;
    if (F.wave < ws_) return;
    const int c8 = F.lane, gi = c8 >> 4, w = 2 << gi, lo = w >> 1, hi = (w >> 1) - 1;
#define POOL_ACC(sgn, V_) do { a[0] sgn bf_lo((V_).x); a[1] sgn bf_hi((V_).x); a[2] sgn bf_lo((V_).y); a[3] sgn bf_hi((V_).y); a[4] sgn bf_lo((V_).z); a[5] sgn bf_hi((V_).z); a[6] sgn bf_lo((V_).w); a[7] sgn bf_hi((V_).w); } while (0)
    for (int task = F.vcu * nw_ + (F.wave - ws_); task < NTOK / 32; task += F.G * nw_) {
        const int row0 = task * 32; const int L = row0 < NPROMPT ? 2048 : 4096, pos0 = row0 & (L - 1), seq0 = row0 - pos0;
        const bf16* col = UP + (size_t)seq0 * 512 + c8 * 8;
        float a[8] = {0.f, 0.f, 0.f, 0.f, 0.f, 0.f, 0.f, 0.f};
        { const int start = max(pos0 - lo, 0), end = min(pos0 + hi + 1, L);
          for (int k0 = 0; k0 < 32; k0 += 8) { v4u x[8];
#pragma unroll
              for (int j = 0; j < 8; ++j) { const int t = start + k0 + j; const bool ok = t < end; x[j] = *(const v4u*)(col + (size_t)(ok ? t : start) * 512); if (!ok) x[j] = (v4u){0u, 0u, 0u, 0u}; }
#pragma unroll
              for (int j = 0; j < 8; ++j) POOL_ACC(+=, x[j]); } }
        for (int r0 = 0; r0 < 32; r0 += 4) { v4u xe[4], xl[4], xs[4];
#pragma unroll
            for (int j = 0; j < 4; ++j) { const int pos = pos0 + r0 + j, ent = pos + hi, lev = pos - lo - 1; const bool ev = (r0 + j > 0) && ent < L, lv = (r0 + j > 0) && lev >= 0;
                xe[j] = *(const v4u*)(col + (size_t)(ev ? ent : pos) * 512); if (!ev) xe[j] = (v4u){0u, 0u, 0u, 0u};
                xl[j] = *(const v4u*)(col + (size_t)(lv ? lev : pos) * 512); if (!lv) xl[j] = (v4u){0u, 0u, 0u, 0u};
                xs[j] = *(const v4u*)(col + (size_t)pos * 512); }
#pragma unroll
            for (int j = 0; j < 4; ++j) { const int pos = pos0 + r0 + j; POOL_ACC(+=, xe[j]); POOL_ACC(-=, xl[j]);
                const float rc = 1.f / (float)(min(pos + hi + 1, L) - max(pos - lo, 0)); const v4u x = xs[j];
                v4u o; o.x = cvt_pk_bf16(a[0] * rc - bf_lo(x.x), a[1] * rc - bf_hi(x.x)); o.y = cvt_pk_bf16(a[2] * rc - bf_lo(x.y), a[3] * rc - bf_hi(x.y));
                o.z = cvt_pk_bf16(a[4] * rc - bf_lo(x.z), a[5] * rc - bf_hi(x.z)); o.w = cvt_pk_bf16(a[6] * rc - bf_lo(x.w), a[7] * rc - bf_hi(x.w));
                *(v4u*)(PL + (size_t)(row0 + r0 + j) * 512 + c8 * 8) = o; } }
    }
#undef POOL_ACC
}
__device__ __forceinline__ void ssm_scan(Frame& F) {
    const bf16* Z = (const bf16*)(F.ws + WS_Z); bf16* SP = (bf16*)(F.ws + WS_SP); const float* AT = (const float*)(F.ws + WS_AT);
    const int p = F.lane;
    for (int u = F.vcu + F.G * F.wave; u < 20 * NGRP * 2; u += F.G * NWAVES) {
        const int dir = u & 1, bg = u >> 1, g = bg & 31, b = bg >> 5;
        const int chunk0 = b < 16 ? b * 128 : 2048 + (b - 16) * 256, nch = b < 16 ? 128 : 256;
        const float ar = AT[((dir * NGRP + g) * 64 + p) * 2], ai = AT[((dir * NGRP + g) * 64 + p) * 2 + 1];
        const bf16* Zg = Z + ((size_t)g * NCHUNK + chunk0) * 256 + dir * 128 + p; bf16* Sg = SP + ((size_t)g * NCHUNK + chunk0) * 256 + dir * 128 + p;
        float sr = 0.f, si = 0.f;
        for (int c0 = 0; c0 < nch; c0 += 16) {
            float zr[16], zi[16];
#pragma unroll
            for (int k = 0; k < 16; ++k) { const int c = dir == 0 ? c0 + k : nch - 1 - (c0 + k); zr[k] = __uint_as_float((unsigned)Zg[(size_t)c * 256] << 16); zi[k] = __uint_as_float((unsigned)Zg[(size_t)c * 256 + 64] << 16); }
#pragma unroll
            for (int k = 0; k < 16; ++k) { const int c = dir == 0 ? c0 + k : nch - 1 - (c0 + k);
                Sg[(size_t)c * 256] = (bf16)(cvt_pk_bf16(sr, 0.f) & 0xffffu); Sg[(size_t)c * 256 + 64] = (bf16)(cvt_pk_bf16(si, 0.f) & 0xffffu);
                const float nr = ar * sr - ai * si + zr[k], ni = ar * si + ai * sr + zi[k]; sr = nr; si = ni; }
        }
    }
}
namespace att {
constexpr int KRING = 0, VRING = 49152;
constexpr int XOFF = 0, OSOFF = 65536, GOFF = OSOFF + 4 * 32 * 272, LDS_USED = GOFF + 512;
constexpr float THR = 8.f;
__device__ __forceinline__ int crow(int r, int hi) { return (r & 3) + 8 * (r >> 2) + 4 * hi; }
__device__ __forceinline__ int swap23(int x) { return (x & ~12) | ((x & 4) << 1) | ((x & 8) >> 1); }
__device__ __forceinline__ float swapf_max(float v) { auto rr = __builtin_amdgcn_permlane32_swap(__float_as_uint(v), __float_as_uint(v), false, false); return fmaxf(__uint_as_float(rr[0]), __uint_as_float(rr[1])); }
__device__ __forceinline__ float swapf_add(float v) { auto rr = __builtin_amdgcn_permlane32_swap(__float_as_uint(v), __float_as_uint(v), false, false); return __uint_as_float(rr[0]) + __uint_as_float(rr[1]); }
__device__ __forceinline__ bf16x8 pack_p(const f32x16& p, int s) { v4u w; w.x = cvt_pk_bf16(p[8 * s], p[8 * s + 1]); w.y = cvt_pk_bf16(p[8 * s + 2], p[8 * s + 3]); w.z = cvt_pk_bf16(p[8 * s + 4], p[8 * s + 5]); w.w = cvt_pk_bf16(p[8 * s + 6], p[8 * s + 7]); return __builtin_bit_cast(bf16x8, w); }

__device__ __forceinline__ void attn_unit(const bf16* __restrict__ Q, const bf16* __restrict__ K, const bf16* __restrict__ VT, bf16* __restrict__ O, const float* subg, float lam, int layer,
                                          int seq0, int L, int h, int qb, LAS unsigned char* lds, int wave_) {
#define FRESH_TID(t) int t; { unsigned z_ = 0u; asm volatile("" : "+v"(z_)); t = wave_ * 64 + (int)__builtin_amdgcn_mbcnt_hi(~0u, __builtin_amdgcn_mbcnt_lo(~0u, z_)); asm volatile("" : "+v"(t)); }
    FRESH_TID(tid_);
    const int wid = __builtin_amdgcn_readfirstlane(tid_ >> 6), comp = wid >> 2, wq = wid & 3;
    f32x16 o[4]; float l_run = 0.f;
    {
    const int tid = tid_, lane = tid & 63, r32 = lane & 31, hi = lane >> 5;
    unsigned koff[2], voff[2];
    const bf16* Kb = K + (size_t)seq0 * 1024 + h * 128; const bf16* Vb = VT + (size_t)(seq0 >> 8) * (1024 * 256) + (size_t)(h * 128) * 256;
#pragma unroll
    for (int i = 0; i < 2; ++i) { const int pc = wid + 8 * i;
        { const int row = (pc & 7) * 8 + (lane >> 3), c = (lane & 7) ^ ((row >> 1) & 7); koff[i] = 2u * (unsigned)(swap23(row) * 1024 + (pc >> 3) * 64 + c * 8); }
        { const int d = pc * 8 + (lane >> 3), c = (lane & 7) ^ ((d >> 1) & 7); voff[i] = 2u * (unsigned)(d * 256 + c * 8); } }
    const unsigned lds_u32 = (unsigned)(uintptr_t)lds + (unsigned)wid * 1024u;
#define DMA_K(t, slot) do { const bf16* kt_ = Kb + (size_t)(t) * 64 * 1024; asm volatile("" : "+s"(kt_));     \
        _Pragma("unroll") for (int i = 0; i < 2; ++i) pg8::glds_saddr(kt_, koff[i], lds_u32 + (unsigned)(KRING + (slot) * 16384 + i * 8192)); } while (0)
#define DMA_V(t, slot) do { const bf16* vt_ = Vb + (size_t)((t) >> 2) * (1024 * 256) + ((t) & 3) * 64; asm volatile("" : "+s"(vt_)); \
        _Pragma("unroll") for (int i = 0; i < 2; ++i) pg8::glds_saddr(vt_, voff[i], lds_u32 + (unsigned)(VRING + (slot) * 16384 + i * 8192)); } while (0)
#define WAIT_BAR() do { asm volatile("s_waitcnt vmcnt(0) lgkmcnt(0)" ::: "memory"); __builtin_amdgcn_s_barrier(); asm volatile("" ::: "memory"); } while (0)
#define WAIT_BAR_N(n) do { asm volatile("s_waitcnt vmcnt(" #n ") lgkmcnt(0)" ::: "memory"); __builtin_amdgcn_s_barrier(); asm volatile("" ::: "memory"); } while (0)
    const int NT = L / 64;
    __syncthreads();
    DMA_K(0, 0); DMA_K(1, 1); DMA_K(2, 2); DMA_V(0, 0);
    bf16x8 qf[4];
    { const bf16* qp = Q + (size_t)(seq0 + qb * 128 + wq * 32 + r32) * 1024 + h * 128 + comp * 64 + hi * 8;
#pragma unroll
      for (int s = 0; s < 4; ++s) qf[s] = *(const bf16x8*)(qp + s * 16); }
    const int sw = (r32 >> 1) & 7; const LAS unsigned char* kbs[4]; const LAS unsigned char* vbs[4];
#pragma unroll
    for (int s = 0; s < 4; ++s) { const int fo = r32 * 128 + (((2 * s + hi) ^ sw) << 4); kbs[s] = lds + KRING + comp * 8192 + fo; vbs[s] = lds + VRING + fo; }
#pragma unroll
    for (int d = 0; d < 4; ++d)
#pragma unroll
        for (int r = 0; r < 16; ++r) o[d][r] = 0.f;
    float m_run = 0.f, alpha = 1.f; bool resc = false; const float thr_ = THR;
    f32x16 pA, pB, pC, pD;
    f32x16 negm;
    v4u pw[4];
    bf16x8 kf[8];
#define SBAR() __builtin_amdgcn_sched_barrier(0)
#define PIN(x) asm volatile("" : "+v"(x))
#define USE(x) asm volatile("" :: "v"(x))
#define SGB(mask, n) __builtin_amdgcn_sched_group_barrier((mask), (n), 0)
#define KFR(kh, s) (*(const LAS bf16x8*)(kbs[s] + (kb_ + (kh) * 4096)))
#define VFR(d, s) (*(const LAS bf16x8*)(vbs[s] + (vb_ + (d) * 4096)))
#define MFMA32(a, b, c) __builtin_amdgcn_mfma_f32_32x32x16_bf16((a), (b), (c), 0, 0, 0)
#define GAPA(C, CIN, kh, s, P, B, W) do { C = MFMA32(kf[(s) * 2 + (kh)], qf[s], CIN); PIN(C); \
        pw[W][((B) >> 1) & 3] = cvt_pk_bf16(P[B], P[B + 1]); pw[W][(((B) >> 1) & 3) + 1] = cvt_pk_bf16(P[B + 2], P[B + 3]); \
        l_run += P[B]; l_run += P[B + 1]; l_run += P[B + 2]; l_run += P[B + 3]; USE(l_run); SBAR(); } while (0)
#define PVM(d, s) o[d] = MFMA32(vf[((d) & 1) * 4 + (s)], __builtin_bit_cast(bf16x8, pw[s]), o[d])
#define MAXF(X, B) "v"(X[B]), "v"(X[B + 1]), "v"(X[B + 2]), "v"(X[B + 3]), "v"(X[B + 4]), "v"(X[B + 5]), "v"(X[B + 6]), "v"(X[B + 7])
#define GAPM_FIRST(d, s, X, B) do { PVM(d, s); asm("v_max3_f32 %0, %2, %3, %4\n\tv_max3_f32 %1, %5, %6, %7\n\tv_max3_f32 %0, %0, %8, %9" : "=&v"(mxa), "=&v"(mxb) : MAXF(X, B)); SBAR(); } while (0)
#define GAPM(d, s, X, B) do { PVM(d, s); asm("v_max3_f32 %0, %0, %2, %3\n\tv_max3_f32 %1, %1, %4, %5\n\tv_max3_f32 %0, %0, %6, %7\n\tv_max3_f32 %1, %1, %8, %9" : "+v"(mxa), "+v"(mxb) : MAXF(X, B)); SBAR(); } while (0)
#define GAPM_LAST(d, s, X, B) do { PVM(d, s); asm("v_max3_f32 %0, %0, %3, %4\n\tv_max3_f32 %1, %1, %5, %6\n\tv_max3_f32 %0, %0, %7, %8\n\tv_max3_f32 %1, %1, %9, %10\n\tv_max_f32 %0, %0, %1\n\tv_cmp_nle_f32 %2, %0, %11" \
        : "+v"(mxa), "+v"(mxb), "=s"(over) : MAXF(X, B), "s"(thr_)); SBAR(); } while (0)
#define GAPE3(d, s, X, B) do { PVM(d, s); X[B] = __builtin_amdgcn_exp2f(X[B]); X[B + 1] = __builtin_amdgcn_exp2f(X[B + 1]); X[B + 2] = __builtin_amdgcn_exp2f(X[B + 2]); PIN(X); SBAR(); } while (0)
#define GAPE2(d, s, X, B) do { PVM(d, s); X[B] = __builtin_amdgcn_exp2f(X[B]); X[B + 1] = __builtin_amdgcn_exp2f(X[B + 1]); PIN(X); SBAR(); } while (0)
#define DECIDE(C0, C1) do { resc = false; \
        if (__builtin_expect(over != 0ull, 0)) { const float mx = swapf_max(mxa); const float dl = fmaxf(mx, 0.f); alpha = __builtin_amdgcn_exp2f(-dl); m_run += dl; l_run *= alpha; resc = true; \
            _Pragma("unroll") for (int r = 0; r < 16; ++r) { C0[r] -= dl; C1[r] -= dl; negm[r] -= dl; } } } while (0)
#define RESCALE() do { if (resc) { _Pragma("unroll") for (int d = 0; d < 4; ++d) _Pragma("unroll") for (int r = 0; r < 16; ++r) o[d][r] *= alpha; } } while (0)
#define KPRE2(kslot, s0) do { constexpr int kb_ = (kslot) * 16384; _Pragma("unroll") for (int s = (s0); s < (s0) + 2; ++s) { kf[2 * s] = KFR(0, s); kf[2 * s + 1] = KFR(1, s); } } while (0)
#define PHASE_A(C0, C1, P0, P1, vslot) do { \
        constexpr int vb_ = (vslot) * 16384; \
        SBAR(); \
        GAPA(C0, negm, 0, 0, P0, 0, 0); GAPA(C1, negm, 1, 0, P0, 4, 0); \
        GAPA(C0, C0, 0, 1, P0, 8, 1); GAPA(C1, C1, 1, 1, P0, 12, 1); \
        GAPA(C0, C0, 0, 2, P1, 0, 2); GAPA(C1, C1, 1, 2, P1, 4, 2); \
        _Pragma("unroll") for (int s = 0; s < 4; ++s) vf[s] = VFR(0, s); SBAR();        \
        GAPA(C0, C0, 0, 3, P1, 8, 3); GAPA(C1, C1, 1, 3, P1, 12, 3); \
        } while (0)
#define PHASE_B(C0, C1, vslot, knext, pre) do { \
        constexpr int vb_ = (vslot) * 16384; \
        _Pragma("unroll") for (int s = 0; s < 4; ++s) vf[4 + s] = VFR(1, s); \
        float mxa, mxb; unsigned long long over; asm volatile("s_nop 15\n\ts_nop 7" : "+v"(C0), "+v"(C1)); SBAR(); \
        GAPM_FIRST(0, 0, C0, 0); GAPM(0, 1, C0, 8); GAPM(0, 2, C1, 0); GAPM_LAST(0, 3, C1, 8); \
        DECIDE(C0, C1); \
        _Pragma("unroll") for (int s = 0; s < 4; ++s) vf[s] = VFR(2, s); SBAR(); \
        GAPE3(1, 0, C0, 0); GAPE3(1, 1, C0, 3); GAPE3(1, 2, C0, 6); GAPE3(1, 3, C0, 9); \
        _Pragma("unroll") for (int s = 0; s < 4; ++s) vf[4 + s] = VFR(3, s); if (pre) KPRE2(knext, 0); SBAR(); \
        GAPE3(2, 0, C0, 12); C0[15] = __builtin_amdgcn_exp2f(C0[15]); GAPE3(2, 1, C1, 0); if (pre) KPRE2(knext, 2); SBAR(); GAPE3(2, 2, C1, 3); GAPE3(2, 3, C1, 6); \
        GAPE3(3, 0, C1, 9); GAPE2(3, 1, C1, 12); GAPE2(3, 2, C1, 14); PVM(3, 3); SBAR(); \
        RESCALE(); } while (0)
#define BOUNDARY(t, S0, SN) do { if ((t) + 2 < NT) WAIT_BAR_N(4); else WAIT_BAR_N(2); \
        if ((t) + 3 < NT) DMA_K((t) + 3, S0); if ((t) + 1 < NT) DMA_V((t) + 1, SN); } while (0)
#define STEP(C0, C1, P0, P1, t, S0, S1, SN) do { BOUNDARY((t), S0, SN); bf16x8 vf[8]; PHASE_A(C0, C1, P0, P1, S1); PHASE_B(C0, C1, S1, SN, ((t) + 1 < NT)); } while (0)
    WAIT_BAR();
    KPRE2(0, 0); KPRE2(0, 2);
    WAIT_BAR_N(0);
    DMA_K(3, 0); DMA_V(1, 1);
    {
#pragma unroll
      for (int r = 0; r < 16; ++r) { pA[r] = 0.f; pB[r] = 0.f; }
#pragma unroll
      for (int s = 0; s < 4; ++s) { pA = MFMA32(kf[2 * s], qf[s], pA); pB = MFMA32(kf[2 * s + 1], qf[s], pB); }
      SBAR(); KPRE2(1, 0); KPRE2(1, 2);
      float mx = fmaxf(pA[0], pB[0]);
#pragma unroll
      for (int r = 1; r < 16; ++r) mx = fmaxf(mx, fmaxf(pA[r], pB[r]));
      m_run = swapf_max(mx);
#pragma unroll
      for (int r = 0; r < 16; ++r) { pA[r] = __builtin_amdgcn_exp2f(pA[r] - m_run); pB[r] = __builtin_amdgcn_exp2f(pB[r] - m_run); negm[r] = -m_run; } }
    if (comp == 1) __builtin_amdgcn_s_setprio(1);
    int t = 1;
    for (; t + 6 < NT; t += 6) {
        STEP(pC, pD, pA, pB, t, 1, 0, 2); STEP(pA, pB, pC, pD, t + 1, 2, 1, 0); STEP(pC, pD, pA, pB, t + 2, 0, 2, 1);
        STEP(pA, pB, pC, pD, t + 3, 1, 0, 2); STEP(pC, pD, pA, pB, t + 4, 2, 1, 0); STEP(pA, pB, pC, pD, t + 5, 0, 2, 1); }
    if (NT == 64) { STEP(pC, pD, pA, pB, 61, 1, 0, 2); STEP(pA, pB, pC, pD, 62, 2, 1, 0); STEP(pC, pD, pA, pB, 63, 0, 2, 1); }
    else { STEP(pC, pD, pA, pB, 31, 1, 0, 2); }
    __builtin_amdgcn_s_setprio(0);
    WAIT_BAR();
    const int vs_last = (NT == 64) ? 0 : 1;
    { const int vb_ = vs_last * 16384;
      float sacc = 0.f;
#pragma unroll
      for (int r = 0; r < 16; ++r) sacc += pC[r] + pD[r];
      l_run += sacc;
      bf16x8 pa[4]; pa[0] = pack_p(pC, 0); pa[1] = pack_p(pC, 1); pa[2] = pack_p(pD, 0); pa[3] = pack_p(pD, 1);
#pragma unroll
      for (int d = 0; d < 4; ++d)
#pragma unroll
          for (int s = 0; s < 4; ++s) o[d] = __builtin_amdgcn_mfma_f32_32x32x16_bf16(VFR(d, s), pa[s], o[d], 0, 0, 0); }
#undef DMA_K
#undef DMA_V
#undef STEP
#undef BOUNDARY
#undef PHASE_A
#undef PHASE_B
#undef KPRE2
#undef GAPA
#undef GAPM
#undef MAXF
#undef GAPM_FIRST
#undef GAPM_LAST
#undef GAPE3
#undef GAPE2
#undef PVM
#undef DECIDE
#undef RESCALE
#undef PIN
#undef USE
#undef SGB
#undef KFR
#undef VFR
    }
    WAIT_BAR();
    FRESH_TID(te_);
#undef FRESH_TID
    const int tid = te_, lane = tid & 63, r32 = lane & 31, hi = lane >> 5;
    const float inv = 1.f / swapf_add(l_run);
    LAS float* X = (LAS float*)(lds + XOFF); LAS float* Gt = (LAS float*)(lds + GOFF);
    if (comp == 1) { const float f = lam * inv;
#pragma unroll
        for (int d = 0; d < 4; ++d)
#pragma unroll
            for (int r = 0; r < 16; ++r) X[(wq * 128 + 32 * d + crow(r, hi)) * 32 + r32] = o[d][r] * f; }
    { int l_ = layer; asm volatile("" : "+s"(l_)); if (tid < 128) Gt[tid] = subg[tid] * (1.f - (0.8f - 0.6f * __expf(-0.3f * (float)l_))); }
    __syncthreads();
    if (comp == 0) {
        float ss = 0.f;
#pragma unroll
        for (int d = 0; d < 4; ++d)
#pragma unroll
            for (int r = 0; r < 16; ++r) { const float v = o[d][r] * inv - X[(wq * 128 + 32 * d + crow(r, hi)) * 32 + r32]; o[d][r] = v; ss += v * v; }
        ss = swapf_add(ss);
        const float rs = rsqrtf(ss * (1.f / 128.f) + RMS_EPS);
        LAS unsigned char* os = lds + OSOFF + wq * (32 * 272);
#pragma unroll
        for (int d = 0; d < 4; ++d)
#pragma unroll
            for (int rg = 0; rg < 4; ++rg) { const int d0 = 32 * d + 8 * rg + 4 * hi; const f32x4 gg = *(const LAS f32x4*)(Gt + d0);
                v2u w; w.x = cvt_pk_bf16(o[d][4 * rg] * rs * gg.x, o[d][4 * rg + 1] * rs * gg.y); w.y = cvt_pk_bf16(o[d][4 * rg + 2] * rs * gg.z, o[d][4 * rg + 3] * rs * gg.w);
                *(LAS v2u*)(os + r32 * 272 + d0 * 2) = w; }
        LDS_WAIT(); asm volatile("" ::: "memory");
        bf16* Ow = O + (size_t)(seq0 + qb * 128 + wq * 32) * DM + h * 128;
#pragma unroll
        for (int i = 0; i < 8; ++i) { const int cid = lane + 64 * i, row = cid >> 4, c16 = cid & 15; const v4u v = *(const LAS v4u*)(os + row * 272 + c16 * 16); *(v4u*)(Ow + (size_t)row * DM + c16 * 8) = v; }
    }
}
struct APtrs { const float *q1, *k1, *q2, *k2, *subln; };
__device__ __forceinline__ void attn_phase(Frame& F, const APtrs& A, int l) {
    const bf16* Q = (const bf16*)(F.ws + WS_Q); const bf16* K = (const bf16*)(F.ws + WS_K); const bf16* VT = (const bf16*)(F.ws + WS_VT); bf16* MIX = (bf16*)(F.ws + WS_HB);
    const float lam_init = 0.8f - 0.6f * expf(-0.3f * (float)l);
    float d1 = 0.f, d2 = 0.f;
    for (int i = 0; i < 64; ++i) { d1 += A.q1[l * 64 + i] * A.k1[l * 64 + i]; d2 += A.q2[l * 64 + i] * A.k2[l * 64 + i]; }
    const float lam = __builtin_bit_cast(float, __builtin_amdgcn_readfirstlane(__builtin_bit_cast(int, expf(d1) - expf(d2) + lam_init)));
    const float* subg = A.subln + l * 128;
    for (int U = F.vcu; U < 1024; U += F.G) { const int bh = U >> 5, qb = U & 31, b = bh >> 3, h = bh & 7; attn_unit(Q, K, VT, MIX, subg, lam, l, NPROMPT + b * 4096, 4096, h, qb, F.lds, F.wave); }
    for (int U = F.vcu; U < 2048; U += F.G) { const int bh = U >> 4, qb = U & 15, b = bh >> 3, h = bh & 7; attn_unit(Q, K, VT, MIX, subg, lam, l, b * 2048, 2048, h, qb, F.lds, F.wave); }
    __syncthreads();
}
}
#ifndef UP_ALIGN
#define UP_ALIGN true
#endif
#ifndef FFN_SP2
#define FFN_SP2 true
#endif
constexpr int NSSMW = NGRP * SSM_SPLIT;
constexpr int NSLAB = 6, SLAB_ROWS = NTOK / NSLAB  , SLAB_PANELS = SLAB_ROWS / 256;
constexpr int PH_PER_LAYER = 7 + NSLAB + 1, NPHASE = 1 + NLAYER * PH_PER_LAYER + 1;
struct Args { const float* in[26]; float* out; unsigned char* ws; int ph_lo, ph_hi, use_bar, pad; };
typedef __attribute__((address_space(4))) const unsigned char* KP;
template <class T> __device__ __forceinline__ T karg(KP kp, int off) { typedef T TT; return *(const __attribute__((address_space(4))) TT*)(kp + off); }
#define KARG(T, off) karg<T>(kp, (off))
__global__ void __launch_bounds__(NWAVES * 64, 2) fwd_kernel(Args args) {
    extern __shared__ __attribute__((aligned(16))) unsigned char lds_raw[];
    Frame F;
    F.lds = (LAS unsigned char*)lds_raw;
    F.tid = threadIdx.x; F.lane = F.tid & 63; F.wave = __builtin_amdgcn_readfirstlane(F.tid >> 6);
    F.G = gridDim.x; { const int bx = blockIdx.x; F.vcu = (F.G % 8 == 0) ? (bx % 8) * (F.G / 8) + bx / 8 : bx; }
    KP kp0 = (KP)__builtin_amdgcn_kernarg_segment_ptr();
    static_assert(sizeof(Args) == 240, "Args layout");
    F.out = nullptr; F.ws = nullptr;
    volatile LAS unsigned* MISC = (volatile LAS unsigned*)(F.lds + MISC_OFF);
    for (int u = F.tid; u < (LDS_BYTES - LDSCTL_OFF) / 4; u += NWAVES * 64) ((LAS unsigned*)(F.lds + LDSCTL_OFF))[u] = 0u;
    __syncthreads();
    KP kp = kp0; asm volatile("" : "+s"(kp));
    unsigned* barw = (unsigned*)(KARG(unsigned char*, 216) + WS_CTL) + CW_BAR;
    XcdBarrier bar; bar.bar = barw; bar.x = 0; bar.st = nullptr;
    if (KARG(int, 232)) bar = xcd_barrier_post(barw, MISC + 8);
    const int lo = KARG(int, 224), hi = KARG(int, 228);
#define IN(k) (lo <= (k) && (k) < hi)
#define SEAM(k) do { if (IN(k) && IN((k) + 1)) xcd_barrier(bar); } while (0)
#define PHASE_FRAME() Frame P; KP kp = kp0; { int g_ = __builtin_amdgcn_readfirstlane(F.G), v_ = __builtin_amdgcn_readfirstlane(F.vcu), w_ = F.wave, c_ = __builtin_amdgcn_readfirstlane((int)blockIdx.x); \
        asm volatile("" : "+s"(kp), "+s"(g_), "+s"(v_), "+s"(w_), "+s"(c_)); \
        unsigned z_ = 0u; asm volatile("" : "+v"(z_)); int t_ = w_ * 64 + (int)__builtin_amdgcn_mbcnt_hi(~0u, __builtin_amdgcn_mbcnt_lo(~0u, z_)); asm volatile("" : "+v"(t_)); \
        P.out = KARG(float*, 208); P.ws = KARG(unsigned char*, 216); P.G = g_; P.vcu = v_; P.tid = t_; P.lane = t_ & 63; P.wave = w_; P.lds = F.lds; cblk = c_; } \
        LAS unsigned char* ring = P.lds
#define AIN(k) KARG(const float*, 8 * (k))
#define WPTRS() WPtrs WP{AIN(3), AIN(21), AIN(17), AIN(19), AIN(20), AIN(23), AIN(24), AIN(2), AIN(22)}
#define SPTRS() SPtrs SS{AIN(9), AIN(10), AIN(11), AIN(12), AIN(13), AIN(14), AIN(15), AIN(16)}
#define WSP(T, off) ((T*)(P.ws + (off)))
#define SS1(l) (WSP(unsigned long long, WS_SS) + (size_t)(l) * NTOK)
#define SS2(l) (WSP(unsigned long long, WS_SS) + (size_t)(5 + (l)) * NTOK)
#define X1P ((bf16*)P.out)
#define X2P ((bf16*)P.out + (size_t)NTOK * DM)
    int cblk = 0;
    if (IN(0)) { PHASE_FRAME(); (void)ring; WPTRS(); SPTRS();
        if (P.G >= 2 * NSSMW) { if (cblk >= NSSMW) convert_weights(P, WP, 0, 7, cblk - NSSMW, P.G - NSSMW); else ssm_weights(P, SS, 0); __syncthreads(); }
        else { convert_weights(P, WP, 0, 7, cblk, P.G); __syncthreads(); ssm_weights(P, SS, 0); }
        input_rows(P, AIN(0), AIN(1), X1P, SS1(0));
        SEAM(0);
    }
    for (int l = 0; l < NLAYER; ++l) {
        const int pb = 1 + l * PH_PER_LAYER;
        if (IN(pb + 0)) { PHASE_FRAME();
            if (l > 0) { WPTRS(); convert_weights(P, WP, l, 2, cblk, P.G); __syncthreads(); }
            { pg8::Gemm g{X1P, WSP(bf16, WS_WIN), NTOK, 3072, DM}; pg8::SchedX<1> S; S.init(NTOK, 3072, P.G, cblk); S.off = 0;
              pg8::EpiInProj E{WSP(bf16, WS_Q), WSP(bf16, WS_K), WSP(bf16, WS_US), WSP(bf16, WS_UP), WSP(const float, WS_ROPE), SS1(l)};
              pg8::gemm_phase<pg8::EpiInProj, pg8::SchedX<1>, true, true>(ring, g, S, E, P.tid); }
            { pg8::Gemm g{WSP(bf16, WS_WIN) + (size_t)2048 * DM, X1P, 1024, NTOK, DM}; pg8::SchedX<0> S; S.init(1024, NTOK, P.G, cblk); S.off = 0;
              pg8::EpiVT E{WSP(bf16, WS_VT), SS1(l)};
              pg8::gemm_phase<pg8::EpiVT, pg8::SchedX<0>, true, true>(ring, g, S, E, P.tid); }
            SEAM(pb + 0);
        }
        if (IN(pb + 1)) { PHASE_FRAME(); int kssm = 256; asm volatile("" : "+s"(kssm));
            { pg8::Gemm g{WSP(bf16, WS_US), WSP(bf16, WS_SSM1), NGRP * NCHUNK, 512, kssm}; pg8::SchedX<2> S; S.init(NGRP * NCHUNK, 512, P.G, cblk); S.off = 0;
              pg8::EpiSsm1 E{WSP(bf16, WS_YI), (size_t)(WS_Z - WS_YI) / 2};
              pg8::gemm_phase<pg8::EpiSsm1, pg8::SchedX<2>, true, true>(ring, g, S, E, P.tid); }
            SEAM(pb + 1);
        }
        if (IN(pb + 2)) { PHASE_FRAME(); (void)ring; ssm_scan(P); pool_prepass(P); SEAM(pb + 2); }
        if (IN(pb + 3)) { PHASE_FRAME(); int kssm = 256; asm volatile("" : "+s"(kssm));
            { pg8::Gemm g{WSP(bf16, WS_SP), WSP(bf16, WS_SSM2), NGRP * NCHUNK, 256, kssm}; pg8::SchedX<3> S; S.init(NGRP * NCHUNK, 256, P.G, cblk); S.off = 0;
              pg8::EpiSsm2 E{WSP(bf16, WS_YI), WSP(bf16, WS_ZB)};
              pg8::gemm_phase<pg8::EpiSsm2, pg8::SchedX<3>, true, true>(ring, g, S, E, P.tid); }
            SEAM(pb + 3);
        }
        if (IN(pb + 4)) { PHASE_FRAME();
            { pg8::Gemm g{WSP(bf16, WS_ZB), WSP(bf16, WS_GP), 2 * NTOK, 1024, 512}; pg8::SchedX<4> S; S.init(NTOK, 1024, P.G, cblk); S.off = 0;
              pg8::EpiGluPool E{WSP(bf16, WS_ZB), AIN(18) + (size_t)l * 512, WSP(bf16, WS_HB)};
              pg8::gemm_phase<pg8::EpiGluPool, pg8::SchedX<4>, true, true>(ring, g, S, E, P.tid); }
            if (!IN(pb + 5)) SEAM(pb + 4);
        }
        if (IN(pb + 5)) { PHASE_FRAME(); (void)ring; att::APtrs AP{AIN(4), AIN(5), AIN(6), AIN(7), AIN(8)}; att::attn_phase(P, AP, l); SEAM(pb + 5); }
        if (IN(pb + 6)) { PHASE_FRAME();
            { pg8::Gemm g{WSP(bf16, WS_HB), WSP(bf16, WS_WOUT), NTOK, DM, DM}; pg8::SchedX<0> S; S.init(NTOK, DM, P.G, cblk); S.off = 0;
              pg8::EpiResidX E{X1P, X2P, SS2(l), 0};
              pg8::gemm_phase<pg8::EpiResidX, pg8::SchedX<0>, true, true>(ring, g, S, E, P.tid); }
            SEAM(pb + 6);
        }
        for (int s = 0; s <= NSLAB; ++s) {
            if (IN(pb + 7 + s)) { PHASE_FRAME();
                if (s == 0 && l + 1 < NLAYER) { WPTRS(); SPTRS();
                    if (P.G >= 2 * NSSMW) { if (cblk >= NSSMW) convert_weights(P, WP, l + 1, 1, cblk - NSSMW, P.G - NSSMW); else ssm_weights(P, SS, l + 1); __syncthreads(); }
                    else { convert_weights(P, WP, l + 1, 1, cblk, P.G); __syncthreads(); ssm_weights(P, SS, l + 1); __syncthreads(); } }
                const int par = 0;
#pragma unroll 1
                for (int k = 0; k < 2; ++k) { int kk = k ^ par; asm volatile("" : "+s"(kk));
                    if (kk == 0) { if (s > 0) { const int sd = s - 1;
                        pg8::Gemm g{WSP(bf16, WS_HID) + (size_t)(sd & 1) * ((size_t)SLAB_ROWS * DFF), WSP(bf16, WS_WDN), SLAB_ROWS, DM, DFF}; pg8::SchedX<0> S; S.init(SLAB_ROWS, DM, P.G, cblk); S.off = 0;
                        pg8::EpiResidX E{X2P, l + 1 < NLAYER ? X1P : WSP(bf16, WS_HB), SS1(l + 1), sd * SLAB_ROWS};
                        pg8::gemm_phase<pg8::EpiResidX, pg8::SchedX<0>, true, FFN_SP2>(ring, g, S, E, P.tid); } }
                    else { if (s < NSLAB) {
                        pg8::Gemm g{X2P, WSP(bf16, WS_WUP), NTOK, DFF, DM}; pg8::SchedX<0> S; S.init(SLAB_ROWS, DFF, P.G, cblk); S.off = s * SLAB_PANELS;
                        pg8::EpiSqRelu E{WSP(bf16, WS_HID) + (size_t)(s & 1) * ((size_t)SLAB_ROWS * DFF), s * SLAB_ROWS, SS2(l)};
                        pg8::gemm_phase<pg8::EpiSqRelu, pg8::SchedX<0>, UP_ALIGN, FFN_SP2>(ring, g, S, E, P.tid); } }
                }
                SEAM(pb + 7 + s);
            }
        }
    }
    if (IN(NPHASE - 1)) { PHASE_FRAME(); (void)ring; final_norm(P, WSP(bf16, WS_HB), AIN(25), SS1(NLAYER)); }
#undef IN
#undef SEAM
}

#ifndef MK_ONE_LAUNCH
#define MK_ONE_LAUNCH 1
#endif
extern "C" void kernel_launch(void* const* d_in, const int* in_sizes, int n_in, void* d_out, int out_size, void* d_ws, size_t ws_size, hipStream_t stream) {
    static int grid = 0;
    if (grid == 0) {
        if (n_in != 26 || out_size != NTOK * DM || ws_size < WS_END) { fprintf(stderr, "kernel_launch: unexpected shapes: n_in %d out %d ws %zu (need %zu)\n", n_in, out_size, ws_size, (size_t)WS_END); grid = -1; return; }
        int dev = 0, cus = 0, per_cu = 0;
        if (hipGetDevice(&dev) != hipSuccess || hipDeviceGetAttribute(&cus, hipDeviceAttributeMultiprocessorCount, dev) != hipSuccess) { grid = -1; return; }
        if (hipFuncSetAttribute((const void*)fwd_kernel, hipFuncAttributeMaxDynamicSharedMemorySize, LDS_BYTES) != hipSuccess) { fprintf(stderr, "kernel_launch: hipFuncSetAttribute failed\n"); grid = -1; return; }
        if (hipOccupancyMaxActiveBlocksPerMultiprocessor(&per_cu, (const void*)fwd_kernel, NWAVES * 64, LDS_BYTES) != hipSuccess || per_cu < 1) fprintf(stderr, "kernel_launch: occupancy query reports %d\n", per_cu);
        (void)hipGetLastError();
        grid = cus;
    }
    if (grid < 0) return;
    if (hipMemsetAsync((char*)d_ws + WS_CTL, 0, CTL_ZERO_BYTES, stream) != hipSuccess) return;
    if (hipMemsetAsync((char*)d_ws + WS_SS, 0, SS_BYTES, stream) != hipSuccess) return;
    Args a{};
    for (int i = 0; i < 26; ++i) a.in[i] = (const float*)d_in[i];
    a.out = (float*)d_out; a.ws = (unsigned char*)d_ws; a.pad = 0;
#if MK_ONE_LAUNCH
    a.ph_lo = 0; a.ph_hi = NPHASE; a.use_bar = 1;
    hipLaunchKernelGGL(fwd_kernel, dim3(grid), dim3(NWAVES * 64), LDS_BYTES, stream, a);
#else
    a.use_bar = 0;
    for (int p = 0; p < NPHASE; ++p) { a.ph_lo = p; a.ph_hi = p + 1; hipLaunchKernelGGL(fwd_kernel, dim3(grid), dim3(NWAVES * 64), LDS_BYTES, stream, a); }
#endif
    const hipError_t le = hipPeekAtLastError();
    if (le != hipSuccess) fprintf(stderr, "kernel_launch: launch failed: %s\n", hipGetErrorName(le));
}
```

```cpp
#include <hip/hip_runtime.h>
#include <hip/hip_bf16.h>
#include <cstdio>
#include <cstdint>
#include <cmath>
constexpr int DM = 2048, NTOK = 49152, NPROMPT = 32768, NLAYER = 4, DFF = 8192;
constexpr int CH_T = 16, NCHUNK = NTOK / CH_T  , NGRP = 32;
constexpr float QSCALE = 0.125f * 1.4426950408889634f;
constexpr float RMS_EPS = 1e-6f;

namespace pg8 {
#define PG8_LAS __attribute__((address_space(3)))
typedef unsigned short bf16_t;
typedef short bf16x8 __attribute__((ext_vector_type(8)));
typedef float f32x4 __attribute__((ext_vector_type(4)));
typedef unsigned u32x4 __attribute__((ext_vector_type(4)));
constexpr int BM = 256, BK = 64, HALF = 128, HTB = HALF * BK * 2  , STAGE_BYTES = 8 * HTB, NXCD = 8, WGM = 8;

__device__ __forceinline__ void glds_saddr(const void* sbase, unsigned voff, unsigned lds_addr) {
    asm volatile("s_mov_b32 m0, %2\n\ts_nop 3\n\tglobal_load_lds_dwordx4 %0, %1" :: "v"(voff), "s"(sbase), "s"(lds_addr) : "memory");
}
__host__ __device__ __forceinline__ int lds_byte(int r, int c) { const int st = (r >> 4) * 2 + (c >> 5), rr = r & 15, cc = c & 31, ob = rr * 64 + cc * 2; return st * 1024 + (ob ^ (((ob >> 9) & 1) << 5)); }
__host__ __device__ __forceinline__ void stage_rc(int b, int& R, int& C) { const int st = b / 1024, sb = b % 1024, swz = sb ^ (((sb >> 9) & 1) << 5); R = (st >> 1) * 16 + swz / 64; C = (st & 1) * 32 + (swz % 64) / 2; }
__host__ __device__ __forceinline__ int perm32(int rho) { const int n = rho >> 4, i = rho & 15; return 8 * (i >> 2) + 4 * n + (i & 3); }

struct Unit { int pm, pn; };
struct Gemm { const bf16_t* A; const bf16_t* Bt; int M, N, K; };

struct StaticOrder {
    int nM, nN, nwg, G, c;
    __host__ __device__ void init(int M, int N, int G_, int c_) { nM = M / BM; nN = N / BM; nwg = nM * nN; G = G_; c = c_; }
    __host__ __device__ bool next(int i, Unit& u) const {
        const long L = (long)i * G + c; if (L >= nwg) return false;
        int wgid = (int)L; { const int q = nwg / NXCD, r = nwg % NXCD, xcd = wgid % NXCD, off = wgid / NXCD; wgid = (xcd < r ? xcd * (q + 1) : r * (q + 1) + (xcd - r) * q) + off; }
        const int nig = WGM * nN, gid = wgid / nig, fm = gid * WGM, gsz = (nM - fm) < WGM ? (nM - fm) : WGM;
        u.pm = fm + ((wgid % nig) % gsz); u.pn = (wgid % nig) / gsz; return true;
    }
    __device__ __forceinline__ void a_ready(const Unit&) const {}
    __device__ __forceinline__ void done(const Unit&) const {}
};
template <int MODE> struct SchedX : StaticOrder {
    int off;
    __device__ __forceinline__ bool next(int i, Unit& u) const {
        if (!StaticOrder::next(i, u)) return false;
        if (MODE == 0) u.pm += off;
        if (MODE == 1) u.pn = u.pn < 8 ? u.pn : u.pn + 4;
        if (MODE == 2) u.pn = (u.pm / 12) * 2 + u.pn;
        if (MODE == 3) u.pn = u.pm / 12;
        if (MODE == 4) { if (u.pn >= 2) u.pm += 192; }
        return true;
    }
};

typedef float f32x2 __attribute__((ext_vector_type(2))); typedef __bf16 bf16x2_t __attribute__((ext_vector_type(2))); typedef unsigned u32x2 __attribute__((ext_vector_type(2)));
__device__ __forceinline__ unsigned cvt_pk_bf16(float lo, float hi) { f32x2 v = {lo, hi}; bf16x2_t b = __builtin_convertvector(v, bf16x2_t); return __builtin_bit_cast(unsigned, b); }
__device__ __forceinline__ float sum_xor16(float v) { auto r = __builtin_amdgcn_permlane16_swap(__float_as_uint(v), __float_as_uint(v), false, false); return __uint_as_float(r[0]) + __uint_as_float(r[1]); }
__device__ __forceinline__ float sum_xor32(float v) { auto r = __builtin_amdgcn_permlane32_swap(__float_as_uint(v), __float_as_uint(v), false, false); return __uint_as_float(r[0]) + __uint_as_float(r[1]); }
__device__ __forceinline__ float get_xor16(float v, bool odd_row) { auto r = __builtin_amdgcn_permlane16_swap(__float_as_uint(v), __float_as_uint(v), false, false); return __uint_as_float(odd_row ? r[0] : r[1]); }
__device__ __forceinline__ float bf_lo(unsigned w) { return __uint_as_float(w << 16); }
__device__ __forceinline__ float bf_hi(unsigned w) { return __uint_as_float(w & 0xffff0000u); }
__device__ __forceinline__ u32x4 pack8(f32x4 a, f32x4 b) { u32x4 w; w.x = cvt_pk_bf16(a[0], a[1]); w.y = cvt_pk_bf16(a[2], a[3]); w.z = cvt_pk_bf16(b[0], b[1]); w.w = cvt_pk_bf16(b[2], b[3]); return w; }

__device__ __forceinline__ float rstd_of(unsigned long long ss) { return __builtin_amdgcn_rsqf((float)ss * (1.f / (1048576.f * DM)) + RMS_EPS); }
struct EpiVT { static constexpr bool PERM = true, AFTER_DRAIN = false; static constexpr bool PERM2 = false; static constexpr int NVM = 16;
    bf16_t* O; const unsigned long long* SS;
    __device__ __forceinline__ void operator()(const f32x4 (&acc)[2][2][4][2], const Unit& u, int wr, int wc, int fr, int fq) const {
        asm volatile("" : "+v"(fr), "+v"(fq));
        const int row0 = u.pm * BM + wr * 64 + fr, cl0 = wc * 32 + 8 * fq, col0 = u.pn * BM + cl0;
        f32x4 r0[2], r1[2];
#pragma unroll
        for (int bj = 0; bj < 2; ++bj)
#pragma unroll
            for (int i = 0; i < 4; ++i) { r0[bj][i] = rstd_of(SS[col0 + bj * HALF + i]); r1[bj][i] = rstd_of(SS[col0 + bj * HALF + 4 + i]); }
        bf16_t* tile = O + (size_t)u.pn * (1024 * 256);
#pragma unroll
        for (int ai = 0; ai < 2; ++ai)
#pragma unroll
            for (int m = 0; m < 4; ++m) { bf16_t* rowp = tile + (size_t)(row0 + ai * HALF + m * 16) * 256 + cl0;
#pragma unroll
                for (int bj = 0; bj < 2; ++bj) *(u32x4*)(rowp + bj * HALF) = pack8(acc[ai][bj][m][0] * r0[bj], acc[ai][bj][m][1] * r1[bj]); }
    }
};
struct EpiInProj { static constexpr bool PERM = true, AFTER_DRAIN = false; static constexpr bool PERM2 = false; static constexpr int NVM = 16;
    bf16_t *Q, *K, *US, *UP; const float* rope; const unsigned long long* SS;
    __device__ __forceinline__ void operator()(const f32x4 (&acc)[2][2][4][2], const Unit& u, int wr, int wc, int fr, int fq) const {
        asm volatile("" : "+v"(fr), "+v"(fq));
        const int pn = u.pn, row0 = u.pm * BM + wr * 64 + fr, cw = wc * 32 + 8 * fq;
        if (pn < 8) {
            bf16_t* base = pn < 4 ? Q : K; const int colt = (pn & 3) * BM; const float sc = pn < 4 ? QSCALE : 1.f;
            const bool ropew = (wc & 1) == 0;
#pragma unroll
            for (int ai = 0; ai < 2; ++ai)
#pragma unroll
                for (int m = 0; m < 4; ++m) { const int row = row0 + ai * HALF + m * 16; const int pos = row < NPROMPT ? (row & 2047) : (row & 4095); const float rstd = rstd_of(SS[row]);
                    f32x4 c0 = {1.f, 1.f, 1.f, 1.f}, c1 = c0, s0 = {0.f, 0.f, 0.f, 0.f}, s1 = s0;
                    if (ropew) { c0 = *(const f32x4*)(rope + pos * 8); c1 = *(const f32x4*)(rope + pos * 8 + 4); s0 = *(const f32x4*)(rope + 32768 + pos * 8); s1 = *(const f32x4*)(rope + 32768 + pos * 8 + 4); }
#pragma unroll
                    for (int bj = 0; bj < 2; ++bj) { f32x4 v0 = acc[ai][bj][m][0], v1 = acc[ai][bj][m][1];
                        if (ropew) { f32x4 o0, o1;
#pragma unroll
                            for (int i = 0; i < 4; ++i) { o0[i] = get_xor16(v0[i], (fq & 1) != 0); o1[i] = get_xor16(v1[i], (fq & 1) != 0); }
                            if (fq == 0) { v0 = v0 * c0 - o0 * s0; v1 = v1 * c1 - o1 * s1; } else if (fq == 1) { v0 = v0 * c0 + o0 * s0; v1 = v1 * c1 + o1 * s1; } }
                        v0 = v0 * (sc * rstd); v1 = v1 * (sc * rstd);
                        *(u32x4*)(base + (size_t)row * 1024 + colt + bj * HALF + cw) = pack8(v0, v1); }
                    asm volatile("" ::: "memory"); }
        } else if (pn < 14) {
#pragma unroll
            for (int ai = 0; ai < 2; ++ai)
#pragma unroll
                for (int m = 0; m < 4; ++m) { const int row = row0 + ai * HALF + m * 16; const float rstd = rstd_of(SS[row]);
#pragma unroll
                    for (int bj = 0; bj < 2; ++bj) { const int cc = (pn - 12) * BM + bj * HALF + cw, g = cc >> 4, h0 = cc & 15;
                        *(u32x4*)(US + ((size_t)g * NTOK + row) * 16 + h0) = pack8(acc[ai][bj][m][0] * rstd, acc[ai][bj][m][1] * rstd); } }
        } else {
#pragma unroll
            for (int ai = 0; ai < 2; ++ai)
#pragma unroll
                for (int m = 0; m < 4; ++m) { const int row = row0 + ai * HALF + m * 16; const float rstd = rstd_of(SS[row]);
#pragma unroll
                    for (int bj = 0; bj < 2; ++bj) { const int cc = (pn - 14) * BM + bj * HALF + cw;
                        *(u32x4*)(UP + (size_t)row * 512 + cc) = pack8(acc[ai][bj][m][0] * rstd, acc[ai][bj][m][1] * rstd); } }
        }
    }
};
struct EpiSsm1 { static constexpr bool PERM = true, AFTER_DRAIN = false; static constexpr bool PERM2 = false; static constexpr int NVM = 16;
    bf16_t* YI; size_t zoff;
    __device__ __forceinline__ void operator()(const f32x4 (&acc)[2][2][4][2], const Unit& u, int wr, int wc, int fr, int fq) const {
        asm volatile("" : "+v"(fr), "+v"(fq));
        const int row0 = u.pm * BM + wr * 64 + fr, col0 = wc * 32 + 8 * fq; bf16_t* O = YI + (size_t)(u.pn & 1) * zoff;
#pragma unroll
        for (int ai = 0; ai < 2; ++ai)
#pragma unroll
            for (int m = 0; m < 4; ++m) { bf16_t* rp = O + (size_t)(row0 + ai * HALF + m * 16) * 256 + col0;
#pragma unroll
                for (int bj = 0; bj < 2; ++bj) *(u32x4*)(rp + bj * HALF) = pack8(acc[ai][bj][m][0], acc[ai][bj][m][1]); }
    }
};
__device__ __forceinline__ float gelu_tanh(float y) {
    const float u2 = 1.5957691216057308f * (y + 0.044715f * y * y * y);
    return y * __builtin_amdgcn_rcpf(1.f + __builtin_amdgcn_exp2f(-1.4426950408889634f * u2));
}
struct EpiSsm2 { static constexpr bool PERM = true, AFTER_DRAIN = false; static constexpr bool PERM2 = false; static constexpr int NVM = 32;
    const bf16_t* YI; bf16_t* ZB;
    __device__ __forceinline__ void operator()(const f32x4 (&acc)[2][2][4][2], const Unit& u, int wr, int wc, int fr, int fq) const {
        asm volatile("" : "+v"(fr), "+v"(fq));
        const int g = u.pn, row0 = u.pm * BM + wr * 64 + fr, col0 = wc * 32 + 8 * fq;
#pragma unroll
        for (int ai = 0; ai < 2; ++ai)
#pragma unroll
            for (int m = 0; m < 4; ++m) { const int row = row0 + ai * HALF + m * 16, chunk = row - g * NCHUNK;
#pragma unroll
                for (int bj = 0; bj < 2; ++bj) { const int col = col0 + bj * HALF; const u32x4 yi = *(const u32x4*)(YI + (size_t)row * 256 + col); const f32x4 a = acc[ai][bj][m][0], b = acc[ai][bj][m][1];
                    const f32x4 v = {gelu_tanh(a[0] + bf_lo(yi.x)), gelu_tanh(a[1] + bf_hi(yi.x)), gelu_tanh(a[2] + bf_lo(yi.y)), gelu_tanh(a[3] + bf_hi(yi.y))};
                    const f32x4 w = {gelu_tanh(b[0] + bf_lo(yi.z)), gelu_tanh(b[1] + bf_hi(yi.z)), gelu_tanh(b[2] + bf_lo(yi.w)), gelu_tanh(b[3] + bf_hi(yi.w))};
                    *(u32x4*)(ZB + (size_t)(chunk * CH_T + (col >> 4)) * 512 + g * 16 + (col & 15)) = pack8(v, w); }
                asm volatile("" ::: "memory"); }
    }
};
struct EpiGluPool { static constexpr bool PERM = true, AFTER_DRAIN = false; static constexpr bool PERM2 = false; static constexpr int NVM = 16;
    const bf16_t* ZB; const float* glu_b; bf16_t* MIX;
    __device__ __forceinline__ void operator()(const f32x4 (&acc)[2][2][4][2], const Unit& u, int wr, int wc, int fr, int fq) const {
        asm volatile("" : "+v"(fr), "+v"(fq));
        const bool glu = u.pn < 2; const int pm = glu ? u.pm : u.pm - 192, pn = glu ? u.pn : u.pn - 2;
        const int row0 = pm * BM + wr * 64 + fr, col0 = pn * BM + wc * 32 + 8 * fq;
#pragma unroll
        for (int ai = 0; ai < 2; ++ai)
#pragma unroll
            for (int m = 0; m < 4; ++m) { const int row = row0 + ai * HALF + m * 16;
#pragma unroll
                for (int bj = 0; bj < 2; ++bj) { const int col = col0 + bj * HALF; f32x4 v0 = acc[ai][bj][m][0], v1 = acc[ai][bj][m][1];
                    if (glu) { const u32x4 zz = *(const u32x4*)(ZB + (size_t)row * 512 + col); const f32x4 b0 = *(const f32x4*)(glu_b + col), b1 = *(const f32x4*)(glu_b + col + 4);
                        const float z[8] = {bf_lo(zz.x), bf_hi(zz.x), bf_lo(zz.y), bf_hi(zz.y), bf_lo(zz.z), bf_hi(zz.z), bf_lo(zz.w), bf_hi(zz.w)};
#pragma unroll
                        for (int i = 0; i < 4; ++i) { v0[i] = z[i] * __builtin_amdgcn_rcpf(1.f + __builtin_amdgcn_exp2f(-1.4426950408889634f * (v0[i] + b0[i])));
                                                      v1[i] = z[4 + i] * __builtin_amdgcn_rcpf(1.f + __builtin_amdgcn_exp2f(-1.4426950408889634f * (v1[i] + b1[i]))); } }
                    *(u32x4*)(MIX + (size_t)row * DM + (glu ? 1024 : 1536) + col) = pack8(v0, v1); } }
    }
};
struct EpiResidX { static constexpr bool PERM = true, AFTER_DRAIN = false; static constexpr bool PERM2 = false; static constexpr int NVM = 32;
    const bf16_t* XI; bf16_t* XO; unsigned long long* SS; int row_off;
    __device__ __forceinline__ void operator()(const f32x4 (&acc)[2][2][4][2], const Unit& u, int wr, int wc, int fr, int fq) const {
        asm volatile("" : "+v"(fr), "+v"(fq));
        const int row0 = u.pm * BM + wr * 64 + fr + row_off, col0 = u.pn * BM + wc * 32 + 8 * fq;
#pragma unroll
        for (int ai = 0; ai < 2; ++ai) {
            u32x4 bv[4][2];
#pragma unroll
            for (int m = 0; m < 4; ++m) { const bf16_t* bp = XI + (size_t)(row0 + ai * HALF + m * 16) * DM + col0;
#pragma unroll
                for (int bj = 0; bj < 2; ++bj) bv[m][bj] = *(const u32x4*)(bp + bj * HALF); }
#pragma unroll
            for (int m = 0; m < 4; ++m) { const int row = row0 + ai * HALF + m * 16; bf16_t* xp = XO + (size_t)row * DM + col0;
                float s = 0.f;
#pragma unroll
                for (int bj = 0; bj < 2; ++bj) { const u32x4 x = bv[m][bj]; const f32x4 a = acc[ai][bj][m][0], b = acc[ai][bj][m][1];
                    const f32x4 v = {bf_lo(x.x) + a[0], bf_hi(x.x) + a[1], bf_lo(x.y) + a[2], bf_hi(x.y) + a[3]}, w = {bf_lo(x.z) + b[0], bf_hi(x.z) + b[1], bf_lo(x.w) + b[2], bf_hi(x.w) + b[3]};
                    s += ((v[0] * v[0] + v[1] * v[1]) + (v[2] * v[2] + v[3] * v[3])) + ((w[0] * w[0] + w[1] * w[1]) + (w[2] * w[2] + w[3] * w[3]));
                    *(u32x4*)(xp + bj * HALF) = pack8(v, w); }
                s = sum_xor32(sum_xor16(s));
                if (fq == 0) __hip_atomic_fetch_add(SS + row, (unsigned long long)(s * 1048576.f + 0.5f), __ATOMIC_RELAXED, __HIP_MEMORY_SCOPE_AGENT); }
            asm volatile("" ::: "memory");
        }
    }
};
struct EpiSqRelu { static constexpr bool PERM = true, AFTER_DRAIN = false; static constexpr bool PERM2 = true; static constexpr int NVM = 16;
    bf16_t* HID; int row_off; const unsigned long long* SS;
    __device__ __forceinline__ void operator()(const f32x4 (&acc)[2][2][4][2], const Unit& u, int wr, int wc, int fr, int fq) const {
        asm volatile("" : "+v"(fr), "+v"(fq));
        const int rown = u.pm * BM + wr * 64 + fr;
        bf16_t* base = HID + (size_t)(u.pm * BM + wr * 64 + (fr & 7) - row_off) * DFF + u.pn * BM + wc * 64 + 32 * (fr >> 3) + 8 * fq;
#pragma unroll
        for (int ai = 0; ai < 2; ++ai)
#pragma unroll
            for (int m = 0; m < 4; ++m) { const float rstd = rstd_of(SS[rown + ai * HALF + m * 16]);
                u32x4 d[2];
#pragma unroll
                for (int bj = 0; bj < 2; ++bj) { f32x4 v0 = acc[ai][bj][m][0], v1 = acc[ai][bj][m][1];
#pragma unroll
                    for (int i = 0; i < 4; ++i) { const float a = fmaxf(v0[i], 0.f) * rstd, b = fmaxf(v1[i], 0.f) * rstd; v0[i] = a * a; v1[i] = b * b; }
                    d[bj] = pack8(v0, v1); }
                u32x4 x, y;
#pragma unroll
                for (int i = 0; i < 4; ++i) { x[i] = (unsigned)__builtin_amdgcn_update_dpp((int)d[0][i], (int)d[1][i], 0x128, 0xF, 0xC, false);
                                              y[i] = (unsigned)__builtin_amdgcn_update_dpp((int)d[1][i], (int)d[0][i], 0x128, 0xF, 0x3, false); }
                bf16_t* p = base + (size_t)(ai * HALF + m * 16) * DFF;
                *(u32x4*)p = x; *(u32x4*)(p + (size_t)8 * DFF) = y; }
    }
};

#ifdef PROBE_EPI2
template <class E> struct Probe2 { static constexpr bool v = false; };
#if PROBE_EPI2 == 1
template <> struct Probe2<EpiInProj> { static constexpr bool v = true; };
template <> struct Probe2<EpiVT> { static constexpr bool v = true; };
#else
template <> struct Probe2<EpiSqRelu> { static constexpr bool v = true; };
#endif
#endif
template <class Epi, class Sched, bool ALIGN_EPI = false, bool SP2 = false>
__device__ __forceinline__ void gemm_phase(PG8_LAS unsigned char* lds, const Gemm g, const Sched& S, const Epi& E, int tid_) {
    asm volatile("" : "+v"(tid_));
    const int tid = tid_, wid = __builtin_amdgcn_readfirstlane(tid >> 6), lane = tid & 63, wr = wid >> 2, wc = wid & 3, fr = lane & 15, fq = lane >> 4;
    const int K = g.K, nt = K / BK;
    unsigned voffA[2], voffB[2];
#pragma unroll
    for (int i = 0; i < 2; ++i) { int R, C; stage_rc(tid * 16 + i * 8192, R, C); const int Rb = Epi::PERM2 ? ((R >> 5) * 64 + perm32(R & 31)) : Epi::PERM ? ((R & ~31) + perm32(R & 31)) : R;
        voffA[i] = (unsigned)(R * K + C) * 2u; voffB[i] = (unsigned)(Rb * K + C) * 2u; }
    const size_t kstep = (size_t)(BK * 2);
    const size_t hstep = (size_t)HALF * K * 2;
    const size_t hstepB = Epi::PERM2 ? (size_t)32 * K * 2 : hstep;
    const size_t tstep = 2 * hstep;
    const unsigned ldsw = (unsigned)wid * 1024u;
    const int aoff = lds_byte(wr * 64 + fr, fq * 8), boff = lds_byte(wc * 32 + fr, fq * 8);
#define PG8_SA(b, h) (((b) * 2 + (h)) * HTB)
#define PG8_SB(b, h) ((4 + (b) * 2 + (h)) * HTB)
    const unsigned lds_u32 = (unsigned)(uintptr_t)lds + ldsw;
#define PG8_STAGE(bufoff, gbase, voff) do { _Pragma("unroll") for (int _i = 0; _i < 2; ++_i) \
        glds_saddr((const char*)(gbase), (voff)[_i], lds_u32 + (unsigned)((bufoff) + _i * 8192)); } while (0)
#define PG8_LDA(dst, b, h) do { _Pragma("unroll") for (int m = 0; m < 4; ++m) _Pragma("unroll") for (int k = 0; k < 2; ++k) dst[m][k] = *(const PG8_LAS bf16x8*)(lds + PG8_SA(b, h) + aoff + m * 2048 + k * 1024); } while (0)
#define PG8_LDB(dst, b, h) do { _Pragma("unroll") for (int n = 0; n < 2; ++n) _Pragma("unroll") for (int k = 0; k < 2; ++k) dst[n][k] = *(const PG8_LAS bf16x8*)(lds + PG8_SB(b, h) + boff + n * 2048 + k * 1024); } while (0)
#define PG8_MMA(ai, bj, At, Bt) do { __builtin_amdgcn_s_setprio(1); _Pragma("unroll") for (int m = 0; m < 4; ++m) _Pragma("unroll") for (int n = 0; n < 2; ++n) _Pragma("unroll") for (int k = 0; k < 2; ++k) \
        acc[ai][bj][m][n] = __builtin_amdgcn_mfma_f32_16x16x32_bf16(Bt[n][k], At[m][k], acc[ai][bj][m][n], 0, 0, 0); __builtin_amdgcn_s_setprio(0); } while (0)
#define PG8_WAIT_V(n) asm volatile("s_waitcnt vmcnt(" #n ")" ::: "memory")
#define PG8_WAIT_L(n) asm volatile("s_waitcnt lgkmcnt(" #n ")" ::: "memory")
#define PG8_WAIT_VR(rx) do { if (rx) asm volatile("s_waitcnt vmcnt(%0)" :: "n"(8 + Epi::NVM) : "memory"); else PG8_WAIT_V(8); } while (0)
#define PG8_BAR __builtin_amdgcn_s_barrier()
#define PG8_SCHED __builtin_amdgcn_sched_barrier(0)
    Unit cur, nxt; int ui = 0;
    if (!S.next(0, cur)) return;
    f32x4 acc[2][2][4][2];
#pragma unroll
    for (int a = 0; a < 2; ++a)
#pragma unroll
        for (int b = 0; b < 2; ++b)
#pragma unroll
            for (int m = 0; m < 4; ++m)
#pragma unroll
                for (int n = 0; n < 2; ++n) acc[a][b][m][n] = (f32x4){0.f, 0.f, 0.f, 0.f};
    bf16x8 At[4][2], B0[2][2], B1[2][2];
    const char* cA = (const char*)g.A + (size_t)cur.pm * tstep; const char* cB = (const char*)g.Bt + (size_t)cur.pn * tstep;
    S.a_ready(cur);
    if constexpr (SP2) {
        PG8_STAGE(PG8_SB(0, 0), cB, voffB); PG8_STAGE(PG8_SB(0, 1), cB + hstepB, voffB); PG8_STAGE(PG8_SA(0, 0), cA, voffA); PG8_STAGE(PG8_SA(0, 1), cA + hstep, voffA);
        if (wr == 1) PG8_BAR;
        PG8_WAIT_V(2); PG8_BAR;
        PG8_STAGE(PG8_SB(1, 0), cB + kstep, voffB); PG8_STAGE(PG8_SA(1, 0), cA + kstep, voffA); PG8_STAGE(PG8_SB(1, 1), cB + hstepB + kstep, voffB);
        PG8_WAIT_V(0); PG8_BAR;
    } else {
        PG8_STAGE(PG8_SB(0, 0), cB, voffB); PG8_STAGE(PG8_SA(0, 0), cA, voffA); PG8_STAGE(PG8_SB(0, 1), cB + hstepB, voffB); PG8_STAGE(PG8_SA(0, 1), cA + hstep, voffA);
        if (wr == 1) PG8_BAR;
        PG8_WAIT_V(4); PG8_BAR;
        PG8_STAGE(PG8_SB(1, 0), cB + kstep, voffB); PG8_STAGE(PG8_SA(1, 0), cA + kstep, voffA); PG8_STAGE(PG8_SB(1, 1), cB + hstepB + kstep, voffB);
        PG8_WAIT_V(6); PG8_BAR;
    }
    for (;;) {
        const bool has_next = S.next(ui + 1, nxt);
        const char* nA = has_next ? (const char*)g.A + (size_t)nxt.pm * tstep : cA; const char* nB = has_next ? (const char*)g.Bt + (size_t)nxt.pn * tstep : cB;
        for (int t = 0; t < nt; t += 2) {
            const bool last = (t == nt - 2);
            const bool relax = SP2 && (t == 0);
            const char* a1 = cA + (size_t)(t + 1) * kstep;
            const char* a2 = last ? nA : cA + (size_t)(t + 2) * kstep; const char* b2 = last ? nB : cB + (size_t)(t + 2) * kstep;
            const char* a3 = a2 + kstep; const char* b3 = b2 + kstep;
            if (last && has_next) S.a_ready(nxt);
            if constexpr (SP2) {
            PG8_LDB(B0, 0, 0); PG8_LDB(B1, 0, 1); PG8_SCHED; PG8_LDA(At, 0, 0); PG8_STAGE(PG8_SA(1, 1), a1 + hstep, voffA);
            PG8_WAIT_VR(relax); PG8_WAIT_L(0); PG8_BAR; PG8_MMA(0, 0, At, B0); PG8_MMA(0, 1, At, B1); PG8_BAR; PG8_SCHED;
            PG8_LDA(At, 0, 1); PG8_STAGE(PG8_SB(0, 0), b2, voffB); PG8_STAGE(PG8_SB(0, 1), b2 + hstepB, voffB); PG8_STAGE(PG8_SA(0, 0), a2, voffA);
            PG8_WAIT_VR(relax); PG8_WAIT_L(0); PG8_BAR; PG8_MMA(1, 0, At, B0); PG8_MMA(1, 1, At, B1); PG8_BAR; PG8_SCHED;
            PG8_LDB(B0, 1, 0); PG8_LDB(B1, 1, 1); PG8_SCHED; PG8_LDA(At, 1, 0); PG8_STAGE(PG8_SA(0, 1), a2 + hstep, voffA);
            PG8_WAIT_V(8); PG8_WAIT_L(0); PG8_BAR; PG8_MMA(0, 0, At, B0); PG8_MMA(0, 1, At, B1); PG8_BAR; PG8_SCHED;
            PG8_LDA(At, 1, 1); PG8_STAGE(PG8_SB(1, 0), b3, voffB); PG8_STAGE(PG8_SB(1, 1), b3 + hstepB, voffB); PG8_STAGE(PG8_SA(1, 0), a3, voffA);
            PG8_WAIT_V(8); PG8_WAIT_L(0); PG8_BAR; PG8_MMA(1, 0, At, B0); PG8_MMA(1, 1, At, B1); PG8_BAR; PG8_SCHED;
            } else {
            PG8_LDB(B0, 0, 0); PG8_SCHED; PG8_LDA(At, 0, 0); PG8_STAGE(PG8_SA(1, 1), a1 + hstep, voffA);
            PG8_WAIT_L(8); PG8_BAR; PG8_WAIT_L(0); PG8_MMA(0, 0, At, B0); PG8_BAR; PG8_SCHED;
            PG8_LDB(B1, 0, 1); PG8_STAGE(PG8_SB(0, 0), b2, voffB);
            PG8_BAR; PG8_WAIT_L(0); PG8_MMA(0, 1, At, B1); PG8_BAR;
            PG8_LDA(At, 0, 1); PG8_STAGE(PG8_SA(0, 0), a2, voffA);
            PG8_BAR; PG8_WAIT_L(0); PG8_MMA(1, 0, At, B0); PG8_BAR; PG8_SCHED;
            PG8_STAGE(PG8_SB(0, 1), b2 + hstepB, voffB);
            PG8_WAIT_V(6); PG8_BAR; PG8_MMA(1, 1, At, B1); PG8_BAR;
            PG8_LDB(B0, 1, 0); PG8_SCHED; PG8_LDA(At, 1, 0); PG8_STAGE(PG8_SA(0, 1), a2 + hstep, voffA);
            PG8_WAIT_L(8); PG8_BAR; PG8_WAIT_L(0); PG8_MMA(0, 0, At, B0); PG8_BAR; PG8_SCHED;
            PG8_LDB(B1, 1, 1); PG8_STAGE(PG8_SB(1, 0), b3, voffB);
            PG8_BAR; PG8_WAIT_L(0); PG8_MMA(0, 1, At, B1); PG8_BAR;
            PG8_LDA(At, 1, 1); PG8_STAGE(PG8_SA(1, 0), a3, voffA);
            PG8_BAR; PG8_WAIT_L(0); PG8_MMA(1, 0, At, B0); PG8_BAR; PG8_SCHED;
            PG8_STAGE(PG8_SB(1, 1), b3 + hstepB, voffB);
            PG8_WAIT_V(6); PG8_BAR; PG8_MMA(1, 1, At, B1); PG8_BAR;
            }
        }
        if constexpr (ALIGN_EPI) { if (wr == 0) PG8_BAR; }
        if constexpr (!Epi::AFTER_DRAIN) { E(acc, cur, wr, wc, fr, fq);
#ifdef PROBE_EPI2
            if constexpr (Probe2<Epi>::v) { asm volatile("" ::: "memory"); E(acc, cur, wr, wc, fr, fq); }
#endif
            S.done(cur); }
        if (!has_next) break;
#pragma unroll
        for (int a = 0; a < 2; ++a)
#pragma unroll
            for (int b = 0; b < 2; ++b)
#pragma unroll
                for (int m = 0; m < 4; ++m)
#pragma unroll
                    for (int n = 0; n < 2; ++n) acc[a][b][m][n] = (f32x4){0.f, 0.f, 0.f, 0.f};
        cur = nxt; cA = nA; cB = nB; ++ui;
        if constexpr (ALIGN_EPI) { if (wr == 1) PG8_BAR; }
    }
    PG8_WAIT_V(0);
    if constexpr (!ALIGN_EPI) { if (wr == 0) PG8_BAR; }
    PG8_BAR;
    if constexpr (Epi::AFTER_DRAIN) { E.fused(acc, cur, wr, wc, fr, fq, lds, wid, lane); S.done(cur); }
#undef PG8_SA
#undef PG8_SB
#undef PG8_STAGE
#undef PG8_LDA
#undef PG8_LDB
#undef PG8_MMA
#undef PG8_WAIT_V
#undef PG8_WAIT_L
#undef PG8_WAIT_VR
#undef PG8_BAR
#undef PG8_SCHED
}
}
constexpr int NWAVES = 8;
constexpr size_t MiB = 1u << 20;
constexpr size_t WS_CTL = 0, CTL_ZERO_BYTES = 1 * MiB;
constexpr size_t WS_SS = 4 * MiB, SS_BYTES = 4 * MiB;
constexpr size_t WS_ROPE = 1 * MiB;
constexpr size_t WS_AT = 2 * MiB;
constexpr size_t WS_WIN = 16 * MiB, WS_WOUT = 32 * MiB, WS_WUP = 40 * MiB, WS_WDN = 72 * MiB;
constexpr size_t WS_SSM1 = 104 * MiB, WS_SSM2 = 112 * MiB, WS_GP = 116 * MiB;
constexpr size_t WS_HB = 120 * MiB;
constexpr size_t WS_Q = 312 * MiB, WS_K = 408 * MiB, WS_VT = 504 * MiB, WS_US = 600 * MiB, WS_UP = 648 * MiB;
constexpr size_t WS_YI = 696 * MiB, WS_Z = 744 * MiB, WS_SP = 840 * MiB, WS_ZB = 888 * MiB, WS_PL = 936 * MiB;
constexpr size_t WS_HID = 312 * MiB;
constexpr size_t WS_END = 984 * MiB;
static_assert(WS_PL == WS_ZB + (size_t)NTOK * 512 * 2 && WS_HID + (size_t)8192 * DFF * 2 <= WS_YI, "ws map");
constexpr int CW_BAR = 4096;
constexpr int RING_BYTES = 131072, LDSCTL_OFF = RING_BYTES, MISC_OFF = LDSCTL_OFF + 320, LDS_BYTES = 147456;

#define GAS __attribute__((address_space(1)))
#define LAS __attribute__((address_space(3)))
typedef unsigned short bf16;
typedef unsigned v4u __attribute__((ext_vector_type(4)));
typedef unsigned v2u __attribute__((ext_vector_type(2)));
typedef float f32x4 __attribute__((ext_vector_type(4)));
typedef float f32x16 __attribute__((ext_vector_type(16)));
typedef short bf16x8 __attribute__((ext_vector_type(8)));
typedef GAS unsigned gu32;
#define LDS_WAIT() asm volatile("s_waitcnt lgkmcnt(0)" ::: "memory")
#define VM_WAIT() asm volatile("s_waitcnt vmcnt(0)" ::: "memory")
using pg8::cvt_pk_bf16; using pg8::bf_lo; using pg8::bf_hi;

#define XB_TMO      128
#define XB_XCNT(j)  (256  + 64 * (j))
#define XB_XSUB(j)  (1280 + 64 * (j))
#define XB_XGEN(j)  (2304 + 64 * (j))
#define XB_TOP      3328
#define XB_TOPGEN   3392
#define XCD_BAR_WORDS 3456
#define XB_SPIN_CAP (1u << 18)

__device__ __forceinline__ unsigned xb_ld(unsigned* p)              { return __hip_atomic_load(p, __ATOMIC_RELAXED, __HIP_MEMORY_SCOPE_AGENT); }
__device__ __forceinline__ unsigned xb_add(unsigned* p, unsigned v) { return __hip_atomic_fetch_add(p, v, __ATOMIC_RELAXED, __HIP_MEMORY_SCOPE_AGENT); }
__device__ __forceinline__ unsigned xb_xcc_id() { return (unsigned)__builtin_amdgcn_s_getreg((3 << 11) | 20) & 0xFu; }
#define XB_SPIN(cond, bar) do { unsigned _sp = 0; while (cond) { __builtin_amdgcn_s_sleep(1); \
    if ((++_sp & 255u) == 0u) { if (xb_ld(&(bar)[XB_TMO])) break; if (_sp > XB_SPIN_CAP) { atomicAdd(&(bar)[XB_TMO], 1u); break; } } } } while (0)

struct XcdBarrier {
    unsigned* bar; unsigned x;
    volatile LAS unsigned* st;
};

__device__ __forceinline__ XcdBarrier xcd_barrier_post(unsigned* bar, volatile LAS unsigned* st) {
    XcdBarrier b; b.bar = bar; b.x = xb_xcc_id(); b.st = st;
    if (threadIdx.x == 0) (void)xb_add(&bar[XB_XCNT(b.x)], 1u);
    return b;
}
__device__ __forceinline__ void xcd_barrier_complete(unsigned* bar, unsigned x, unsigned& nloc, unsigned& nx) {
    const unsigned G = gridDim.x * gridDim.y * gridDim.z;
    unsigned sum, cnt, mine, sp = 0u;
    for (;;) {
        sum = 0u; cnt = 0u; mine = 0u;
#pragma unroll
        for (unsigned j = 0; j < 16; ++j) { const unsigned c = xb_ld(&bar[XB_XCNT(j)]); sum += c; cnt += (c > 0u) ? 1u : 0u; mine = (j == x) ? c : mine; }
        if (sum == G) break;
        __builtin_amdgcn_s_sleep(1);
        if ((++sp & 255u) == 0u) { if (xb_ld(&bar[XB_TMO])) break; if (sp > XB_SPIN_CAP) { atomicAdd(&bar[XB_TMO], 1u); break; } }
    }
    nloc = mine > 0u ? mine : 1u; nx = cnt > 0u ? cnt : 1u;
}

__device__ __forceinline__ void xcd_barrier(const XcdBarrier& b) {
    asm volatile("s_waitcnt vmcnt(0)" ::: "memory");
    __syncthreads();
    if (threadIdx.x == 0) {
        unsigned* bar = b.bar;
        __builtin_amdgcn_s_waitcnt(0);
        unsigned nloc = b.st[0], nx = b.st[1];
        if (nloc == 0u) { xcd_barrier_complete(bar, b.x, nloc, nx); b.st[0] = nloc; b.st[1] = nx; }
        const unsigned old = xb_add(&bar[XB_XSUB(b.x)], 1u);
        const unsigned gen = old / nloc;
        if (old + 1u == (gen + 1u) * nloc) {
            __builtin_amdgcn_fence(__ATOMIC_RELEASE, "agent");
            asm volatile("s_waitcnt vmcnt(0)" ::: "memory");
            const unsigned og = xb_add(&bar[XB_TOP], 1u);
            const unsigned tg = og / nx;
            if (og + 1u == (tg + 1u) * nx) xb_add(&bar[XB_TOPGEN], 1u);
            else XB_SPIN(xb_ld(&bar[XB_TOPGEN]) == tg, bar);
            __builtin_amdgcn_fence(__ATOMIC_ACQUIRE, "agent");
            xb_add(&bar[XB_XGEN(b.x)], 1u);
            asm volatile("s_waitcnt vmcnt(0)" ::: "memory");
        } else {
            XB_SPIN(xb_ld(&bar[XB_XGEN(b.x)]) == gen, bar);
            __builtin_amdgcn_fence(__ATOMIC_ACQUIRE, "agent");
            asm volatile("s_waitcnt vmcnt(0)" ::: "memory");
        }
    }
    __syncthreads();
}
struct Frame {
    LAS unsigned char* lds;
    int tid, lane, wave, vcu, G;
    float* out; unsigned char* ws;
};
__device__ __forceinline__ float wave_sum(float v, int lane) {
#pragma unroll
    for (int o = 1; o < 16; o <<= 1) v += __uint_as_float((unsigned)__builtin_amdgcn_ds_bpermute((lane ^ o) << 2, (int)__float_as_uint(v)));
    return pg8::sum_xor32(pg8::sum_xor16(v));
}
__device__ __forceinline__ void transpose_item(const float* W, int K, int N, bf16* WT, LAS float* scr, int item, int lane, const float* gain = nullptr) {
    const int nblk = N / 32, kb = item / nblk, nb = item % nblk, k0 = 64 * kb, n0 = 32 * nb;
    { const int kr = lane >> 3, nq = (lane & 7) * 4; pg8::f32x4 v[8]; float gk[8];
#pragma unroll
      for (int i = 0; i < 8; ++i) { const int kk = 8 * i + kr; v[i] = *(const pg8::f32x4*)(W + (size_t)(k0 + kk) * N + n0 + nq); gk[i] = gain ? gain[k0 + kk] : 1.f; }
#pragma unroll
      for (int i = 0; i < 8; ++i) { const int kk = 8 * i + kr; LAS float* d = scr + kk * 33 + nq; d[0] = v[i].x * gk[i]; d[1] = v[i].y * gk[i]; d[2] = v[i].z * gk[i]; d[3] = v[i].w * gk[i]; } }
    LDS_WAIT(); asm volatile("" ::: "memory");
    const int c = lane & 7;
#pragma unroll
    for (int j = 0; j < 4; ++j) { const int n = (lane >> 3) + 8 * j; const LAS float* s = scr + (8 * c) * 33 + n;
        v4u o; o.x = cvt_pk_bf16(s[0 * 33], s[1 * 33]); o.y = cvt_pk_bf16(s[2 * 33], s[3 * 33]); o.z = cvt_pk_bf16(s[4 * 33], s[5 * 33]); o.w = cvt_pk_bf16(s[6 * 33], s[7 * 33]);
        *(v4u*)(WT + (size_t)(n0 + n) * K + k0 + 8 * c) = o; }
    LDS_WAIT(); asm volatile("" ::: "memory");
}
struct WPtrs { const float *w_in, *w_out, *glu_w, *pool_w, *pool_s, *w_up, *w_dn, *g_mix, *g_mlp; };
__device__ __forceinline__ void convert_weights(Frame& F, const WPtrs& W, int l, int what, int cu_idx, int cu_cnt) {
    LAS float* scr = (LAS float*)(F.lds + F.wave * 16384);
    const int gw = cu_idx * NWAVES + F.wave, NGW = cu_cnt * NWAVES;
    bf16* Win_t = (bf16*)(F.ws + WS_WIN); bf16* Wout_t = (bf16*)(F.ws + WS_WOUT); bf16* Wup_t = (bf16*)(F.ws + WS_WUP); bf16* Wdn_t = (bf16*)(F.ws + WS_WDN); bf16* GP = (bf16*)(F.ws + WS_GP);
    if (what & 1) {
        const float* w_in = W.w_in + (size_t)l * DM * 4096; const float* w_out = W.w_out + (size_t)l * DM * DM; const float* glu_w = W.glu_w + (size_t)l * 512 * 512;
        constexpr int I_IN = (DM / 64) * (4096 / 32), I_OUT = (DM / 64) * (DM / 32), I_GLU = (512 / 64) * (512 / 32);
        for (int it = gw; it < I_IN + I_OUT + I_GLU; it += NGW) {
            int r = it;
            if (r < I_IN) { transpose_item(w_in, DM, 4096, Win_t, scr, r, F.lane, W.g_mix + (size_t)l * DM); continue; } r -= I_IN;
            if (r < I_OUT) { transpose_item(w_out, DM, DM, Wout_t, scr, r, F.lane); continue; } r -= I_OUT;
            transpose_item(glu_w, 512, 512, GP, scr, r, F.lane);
        }
        const float* pool_w = W.pool_w + (size_t)l * 4 * 128 * 128; const float* pool_s = W.pool_s + (size_t)l * 512;
        for (int e = (cu_idx * 512 + F.tid); e < 512 * 512; e += cu_cnt * 512) { const int n = e >> 9, k = e & 511, gi = n >> 7, gj = k >> 7;
            const float v = (gi == gj) ? pool_w[((size_t)gi * 128 + (k & 127)) * 128 + (n & 127)] * pool_s[n] : 0.f;
            GP[(size_t)(512 + n) * 512 + k] = (bf16)(cvt_pk_bf16(v, 0.f) & 0xffffu); }
    }
    if (what & 2) {
        const float* w_up = W.w_up + (size_t)l * DM * DFF; const float* w_dn = W.w_dn + (size_t)l * DFF * DM;
        constexpr int I_UP = (DM / 64) * (DFF / 32), I_DN = (DFF / 64) * (DM / 32);
        for (int it = gw; it < I_UP + I_DN; it += NGW) {
            if (it < I_UP) transpose_item(w_up, DM, DFF, Wup_t, scr, it, F.lane, W.g_mlp + (size_t)l * DM); else transpose_item(w_dn, DFF, DM, Wdn_t, scr, it - I_UP, F.lane);
        }
    }
    if (what & 4) {
        float* rope = (float*)(F.ws + WS_ROPE);
        for (int e = cu_idx * 512 + F.tid; e < 4096 * 8; e += cu_cnt * 512) { const int pos = e >> 3, j = e & 7;
            const float inv = powf(500000.0f, -(float)(2 * j) / 16.0f); const float ang = (float)pos * inv; float s, c; sincosf(ang, &s, &c);
            rope[e] = c; rope[32768 + e] = s; }
    }
}
struct SPtrs { const float *lam_re, *lam_im, *log_dt, *b_re, *b_im, *c_re, *c_im, *d; };
constexpr int SSM_SPLIT = 4;
__device__ __forceinline__ void ssm_weights(Frame& F, const SPtrs& S, int l) {
    typedef float f2 __attribute__((ext_vector_type(2)));
    LAS f2* AP = (LAS f2*)F.lds;
    LAS f2* BB = AP + 2 * 64 * 17;
    LAS f2* CC = BB + 2 * 64 * 16;
    LAS float* KT = (LAS float*)(CC + 2 * 16 * 64);
    const float* lam_re = S.lam_re; const float* lam_im = S.lam_im; const float* log_dt = S.log_dt;
    const float* b_re = S.b_re; const float* b_im = S.b_im; const float* c_re = S.c_re; const float* c_im = S.c_im; const float* dskip = S.d + (size_t)l * 512;
    bf16* W1 = (bf16*)(F.ws + WS_SSM1); bf16* W2 = (bf16*)(F.ws + WS_SSM2); float* AT = (float*)(F.ws + WS_AT);
    for (int task = blockIdx.x; task < NGRP * SSM_SPLIT; task += F.G) { const int g = task / SSM_SPLIT, sq = task % SSM_SPLIT;
        __syncthreads();
        if (F.tid < 128) { const int dir = F.tid >> 6, p = F.tid & 63; const int idx = (l * 2 + dir) * NGRP + g;
            const float lr = lam_re[(size_t)idx * 64 + p], li = lam_im[(size_t)idx * 64 + p], dt = expf(log_dt[idx]);
            for (int k = 0; k <= 16; ++k) { const float mag = expf(lr * dt * (float)k); float s, c; sincosf(li * dt * (float)k, &s, &c); AP[(dir * 64 + p) * 17 + k] = (f2){mag * c, mag * s}; }
            float s1, c1; sincosf(li * dt, &s1, &c1); const float mag1 = expf(lr * dt), ai = mag1 * s1; const float sh = sinf(0.5f * li * dt);
            const float nr = expm1f(lr * dt) * c1 - 2.f * sh * sh;
            const float den = lr * lr + li * li, cr = (nr * lr + ai * li) / den, ci = (ai * lr - nr * li) / den;
            for (int h = 0; h < 16; ++h) { const float br = b_re[((size_t)idx * 64 + p) * 16 + h], bi = b_im[((size_t)idx * 64 + p) * 16 + h]; BB[(dir * 64 + p) * 16 + h] = (f2){cr * br - ci * bi, cr * bi + ci * br}; }
            if (sq == 0) { const f2 a16 = AP[(dir * 64 + p) * 17 + 16]; AT[((dir * NGRP + g) * 64 + p) * 2] = a16.x; AT[((dir * NGRP + g) * 64 + p) * 2 + 1] = a16.y; }
        }
        for (int e = F.tid; e < 2 * 16 * 64; e += 512) { const int dir = e >> 10, h = (e >> 6) & 15, p = e & 63; const size_t gi = (((size_t)(l * 2 + dir) * NGRP + g) * 16 + h) * 64 + p; CC[e] = (f2){c_re[gi], c_im[gi]}; }
        __syncthreads();
        for (int e_ = F.tid; e_ < 8192 / SSM_SPLIT; e_ += 512) { const int dir = e_ >> 10, k = (e_ >> 6) & 15, h = 4 * sq + ((e_ >> 4) & 3), hp = e_ & 15, e = ((dir * 16 + k) * 16 + h) * 16 + hp; float acc = 0.f;
            for (int p = 0; p < 64; ++p) { const f2 c = CC[(dir * 16 + h) * 64 + p], a = AP[(dir * 64 + p) * 17 + k], b = BB[(dir * 64 + p) * 16 + hp];
                const float wr = c.x * a.x - c.y * a.y, wi = c.x * a.y + c.y * a.x; acc += wr * b.x - wi * b.y; }
            KT[e] = acc; }
        __syncthreads();
        for (int e = F.tid; e < 128 * 256; e += 512) { const int r = e >> 8, n = r < 64 ? (r >> 2) * 16 + 4 * sq + (r & 3) : 256 + 64 * sq + (r - 64), kk = e & 255, j = kk >> 4, hp = kk & 15; float v;
            if (n < 256) { const int i = n >> 4, h = n & 15; v = 0.f;
                if (j <= i) v += KT[((0 * 16 + (i - j)) * 16 + h) * 16 + hp];
                if (j >= i) v += KT[((1 * 16 + (j - i)) * 16 + h) * 16 + hp];
                if (i == j && h == hp) v += dskip[g * 16 + h];
            } else { const int q = n - 256, dir = q >> 7, p = q & 63, im = (q >> 6) & 1, ex = dir == 0 ? 15 - j : j; const f2 a = AP[(dir * 64 + p) * 17 + ex], b = BB[(dir * 64 + p) * 16 + hp];
                v = im ? a.x * b.y + a.y * b.x : a.x * b.x - a.y * b.y; }
            W1[((size_t)g * 512 + n) * 256 + kk] = (bf16)(cvt_pk_bf16(v, 0.f) & 0xffffu); }
        for (int e = F.tid; e < 64 * 256; e += 512) { const int r = e >> 8, n = (r >> 2) * 16 + 4 * sq + (r & 3), kk = e & 255, i = n >> 4, h = n & 15, dir = kk >> 7, p = kk & 63, im = (kk >> 6) & 1, ex = dir == 0 ? i + 1 : 16 - i;
            const f2 c = CC[(dir * 16 + h) * 64 + p], a = AP[(dir * 64 + p) * 17 + ex]; const float wr = c.x * a.x - c.y * a.y, wi = c.x * a.y + c.y * a.x;
            W2[((size_t)g * 256 + n) * 256 + kk] = (bf16)(cvt_pk_bf16(im ? -wi : wr, 0.f) & 0xffffu); }
    }
    __syncthreads();
}
__device__ __forceinline__ void input_rows(Frame& F, const float* x0, const float* x1, bf16* o, unsigned long long* SS) {
    const int gw = F.vcu * NWAVES + F.wave, NGW = F.G * NWAVES;
    for (int row = gw; row < NTOK; row += NGW) {
        const float* xr = row < NPROMPT ? x0 + (size_t)row * DM : x1 + (size_t)(row - NPROMPT) * DM;
        f32x4 v[8]; float s = 0.f;
#pragma unroll
        for (int j = 0; j < 8; ++j) { v[j] = ((const f32x4*)xr)[F.lane + 64 * j]; s += (v[j].x * v[j].x + v[j].y * v[j].y) + (v[j].z * v[j].z + v[j].w * v[j].w); }
        s = wave_sum(s, F.lane); if (F.lane == 0) SS[row] = (unsigned long long)(s * 1048576.f + 0.5f);
#pragma unroll
        for (int j = 0; j < 8; ++j) { v2u w; w.x = cvt_pk_bf16(v[j].x, v[j].y); w.y = cvt_pk_bf16(v[j].z, v[j].w); ((v2u*)(o + (size_t)row * DM))[F.lane + 64 * j] = w; }
    }
}
__device__ __forceinline__ void final_norm(Frame& F, const bf16* X, const float* g, const unsigned long long* SS) {
    const int gw = F.vcu * NWAVES + F.wave, NGW = F.G * NWAVES;
    for (int row = gw; row < NTOK; row += NGW) {
        const v2u* xr = (const v2u*)(X + (size_t)row * DM); f32x4* orow = (f32x4*)(F.out + (size_t)row * DM);
        const float rstd = pg8::rstd_of(SS[row]);
#pragma unroll
        for (int j = 0; j < 8; ++j) { const v2u x = xr[F.lane + 64 * j]; const f32x4 gg = ((const f32x4*)g)[F.lane + 64 * j];
            f32x4 o; o.x = bf_lo(x.x) * rstd * gg.x; o.y = bf_hi(x.x) * rstd * gg.y; o.z = bf_lo(x.y) * rstd * gg.z; o.w = bf_hi(x.y) * rstd * gg.w;
            orow[F.lane + 64 * j] = o; }
    }
}
__device__ __forceinline__ void pool_prepass(Frame& F) {
    const bf16* __restrict__ UP = (const bf16*)(F.ws + WS_UP); bf16* __restrict__ PL = (bf16*)(F.ws + WS_PL);
    const int ws_ = (F.G >= 256) ? 5 : 0, nw_ = NWAVES - ws_;
    if (F.wave < ws_) return;
    const int c8 = F.lane, gi = c8 >> 4, w = 2 << gi, lo = w >> 1, hi = (w >> 1) - 1;
#define POOL_ACC(sgn, V_) do { a[0] sgn bf_lo((V_).x); a[1] sgn bf_hi((V_).x); a[2] sgn bf_lo((V_).y); a[3] sgn bf_hi((V_).y); a[4] sgn bf_lo((V_).z); a[5] sgn bf_hi((V_).z); a[6] sgn bf_lo((V_).w); a[7] sgn bf_hi((V_).w); } while (0)
    for (int task = F.vcu * nw_ + (F.wave - ws_); task < NTOK / 32; task += F.G * nw_) {
        const int row0 = task * 32; const int L = row0 < NPROMPT ? 2048 : 4096, pos0 = row0 & (L - 1), seq0 = row0 - pos0;
        const bf16* col = UP + (size_t)seq0 * 512 + c8 * 8;
        float a[8] = {0.f, 0.f, 0.f, 0.f, 0.f, 0.f, 0.f, 0.f};
        { const int start = max(pos0 - lo, 0), end = min(pos0 + hi + 1, L);
          for (int k0 = 0; k0 < 32; k0 += 8) { v4u x[8];
#pragma unroll
              for (int j = 0; j < 8; ++j) { const int t = start + k0 + j; const bool ok = t < end; x[j] = *(const v4u*)(col + (size_t)(ok ? t : start) * 512); if (!ok) x[j] = (v4u){0u, 0u, 0u, 0u}; }
#pragma unroll
              for (int j = 0; j < 8; ++j) POOL_ACC(+=, x[j]); } }
        for (int r0 = 0; r0 < 32; r0 += 4) { v4u xe[4], xl[4], xs[4];
#pragma unroll
            for (int j = 0; j < 4; ++j) { const int pos = pos0 + r0 + j, ent = pos + hi, lev = pos - lo - 1; const bool ev = (r0 + j > 0) && ent < L, lv = (r0 + j > 0) && lev >= 0;
                xe[j] = *(const v4u*)(col + (size_t)(ev ? ent : pos) * 512); if (!ev) xe[j] = (v4u){0u, 0u, 0u, 0u};
                xl[j] = *(const v4u*)(col + (size_t)(lv ? lev : pos) * 512); if (!lv) xl[j] = (v4u){0u, 0u, 0u, 0u};
                xs[j] = *(const v4u*)(col + (size_t)pos * 512); }
#pragma unroll
            for (int j = 0; j < 4; ++j) { const int pos = pos0 + r0 + j; POOL_ACC(+=, xe[j]); POOL_ACC(-=, xl[j]);
                const float rc = 1.f / (float)(min(pos + hi + 1, L) - max(pos - lo, 0)); const v4u x = xs[j];
                v4u o; o.x = cvt_pk_bf16(a[0] * rc - bf_lo(x.x), a[1] * rc - bf_hi(x.x)); o.y = cvt_pk_bf16(a[2] * rc - bf_lo(x.y), a[3] * rc - bf_hi(x.y));
                o.z = cvt_pk_bf16(a[4] * rc - bf_lo(x.z), a[5] * rc - bf_hi(x.z)); o.w = cvt_pk_bf16(a[6] * rc - bf_lo(x.w), a[7] * rc - bf_hi(x.w));
                *(v4u*)(PL + (size_t)(row0 + r0 + j) * 512 + c8 * 8) = o; } }
    }
#undef POOL_ACC
}
__device__ __forceinline__ void ssm_scan(Frame& F) {
    const bf16* Z = (const bf16*)(F.ws + WS_Z); bf16* SP = (bf16*)(F.ws + WS_SP); const float* AT = (const float*)(F.ws + WS_AT);
    const int p = F.lane;
    for (int u = F.vcu + F.G * F.wave; u < 20 * NGRP * 2; u += F.G * NWAVES) {
        const int dir = u & 1, bg = u >> 1, g = bg & 31, b = bg >> 5;
        const int chunk0 = b < 16 ? b * 128 : 2048 + (b - 16) * 256, nch = b < 16 ? 128 : 256;
        const float ar = AT[((dir * NGRP + g) * 64 + p) * 2], ai = AT[((dir * NGRP + g) * 64 + p) * 2 + 1];
        const bf16* Zg = Z + ((size_t)g * NCHUNK + chunk0) * 256 + dir * 128 + p; bf16* Sg = SP + ((size_t)g * NCHUNK + chunk0) * 256 + dir * 128 + p;
        float sr = 0.f, si = 0.f;
        for (int c0 = 0; c0 < nch; c0 += 16) {
            float zr[16], zi[16];
#pragma unroll
            for (int k = 0; k < 16; ++k) { const int c = dir == 0 ? c0 + k : nch - 1 - (c0 + k); zr[k] = __uint_as_float((unsigned)Zg[(size_t)c * 256] << 16); zi[k] = __uint_as_float((unsigned)Zg[(size_t)c * 256 + 64] << 16); }
#pragma unroll
            for (int k = 0; k < 16; ++k) { const int c = dir == 0 ? c0 + k : nch - 1 - (c0 + k);
                Sg[(size_t)c * 256] = (bf16)(cvt_pk_bf16(sr, 0.f) & 0xffffu); Sg[(size_t)c * 256 + 64] = (bf16)(cvt_pk_bf16(si, 0.f) & 0xffffu);
                const float nr = ar * sr - ai * si + zr[k], ni = ar * si + ai * sr + zi[k]; sr = nr; si = ni; }
        }
    }
}
namespace att {
constexpr int KRING = 0, VRING = 49152;
constexpr int XOFF = 0, OSOFF = 65536, GOFF = OSOFF + 4 * 32 * 272, LDS_USED = GOFF + 512;
constexpr float THR = 8.f;
__device__ __forceinline__ int crow(int r, int hi) { return (r & 3) + 8 * (r >> 2) + 4 * hi; }
__device__ __forceinline__ int swap23(int x) { return (x & ~12) | ((x & 4) << 1) | ((x & 8) >> 1); }
__device__ __forceinline__ float swapf_max(float v) { auto rr = __builtin_amdgcn_permlane32_swap(__float_as_uint(v), __float_as_uint(v), false, false); return fmaxf(__uint_as_float(rr[0]), __uint_as_float(rr[1])); }
__device__ __forceinline__ float swapf_add(float v) { auto rr = __builtin_amdgcn_permlane32_swap(__float_as_uint(v), __float_as_uint(v), false, false); return __uint_as_float(rr[0]) + __uint_as_float(rr[1]); }
__device__ __forceinline__ bf16x8 pack_p(const f32x16& p, int s) { v4u w; w.x = cvt_pk_bf16(p[8 * s], p[8 * s + 1]); w.y = cvt_pk_bf16(p[8 * s + 2], p[8 * s + 3]); w.z = cvt_pk_bf16(p[8 * s + 4], p[8 * s + 5]); w.w = cvt_pk_bf16(p[8 * s + 6], p[8 * s + 7]); return __builtin_bit_cast(bf16x8, w); }

__device__ __forceinline__ void attn_unit(const bf16* __restrict__ Q, const bf16* __restrict__ K, const bf16* __restrict__ VT, bf16* __restrict__ O, const float* subg, float lam, int layer,
                                          int seq0, int L, int h, int qb, LAS unsigned char* lds, int wave_) {
#define FRESH_TID(t) int t; { unsigned z_ = 0u; asm volatile("" : "+v"(z_)); t = wave_ * 64 + (int)__builtin_amdgcn_mbcnt_hi(~0u, __builtin_amdgcn_mbcnt_lo(~0u, z_)); asm volatile("" : "+v"(t)); }
    FRESH_TID(tid_);
    const int wid = __builtin_amdgcn_readfirstlane(tid_ >> 6), comp = wid >> 2, wq = wid & 3;
    f32x16 o[4]; float l_run = 0.f;
    {
    const int tid = tid_, lane = tid & 63, r32 = lane & 31, hi = lane >> 5;
    unsigned koff[2], voff[2];
    const bf16* Kb = K + (size_t)seq0 * 1024 + h * 128; const bf16* Vb = VT + (size_t)(seq0 >> 8) * (1024 * 256) + (size_t)(h * 128) * 256;
#pragma unroll
    for (int i = 0; i < 2; ++i) { const int pc = wid + 8 * i;
        { const int row = (pc & 7) * 8 + (lane >> 3), c = (lane & 7) ^ ((row >> 1) & 7); koff[i] = 2u * (unsigned)(swap23(row) * 1024 + (pc >> 3) * 64 + c * 8); }
        { const int d = pc * 8 + (lane >> 3), c = (lane & 7) ^ ((d >> 1) & 7); voff[i] = 2u * (unsigned)(d * 256 + c * 8); } }
    const unsigned lds_u32 = (unsigned)(uintptr_t)lds + (unsigned)wid * 1024u;
#define DMA_K(t, slot) do { const bf16* kt_ = Kb + (size_t)(t) * 64 * 1024; asm volatile("" : "+s"(kt_));     \
        _Pragma("unroll") for (int i = 0; i < 2; ++i) pg8::glds_saddr(kt_, koff[i], lds_u32 + (unsigned)(KRING + (slot) * 16384 + i * 8192)); } while (0)
#define DMA_V(t, slot) do { const bf16* vt_ = Vb + (size_t)((t) >> 2) * (1024 * 256) + ((t) & 3) * 64; asm volatile("" : "+s"(vt_)); \
        _Pragma("unroll") for (int i = 0; i < 2; ++i) pg8::glds_saddr(vt_, voff[i], lds_u32 + (unsigned)(VRING + (slot) * 16384 + i * 8192)); } while (0)
#define WAIT_BAR() do { asm volatile("s_waitcnt vmcnt(0) lgkmcnt(0)" ::: "memory"); __builtin_amdgcn_s_barrier(); asm volatile("" ::: "memory"); } while (0)
#define WAIT_BAR_N(n) do { asm volatile("s_waitcnt vmcnt(" #n ") lgkmcnt(0)" ::: "memory"); __builtin_amdgcn_s_barrier(); asm volatile("" ::: "memory"); } while (0)
    const int NT = L / 64;
    __syncthreads();
    DMA_K(0, 0); DMA_K(1, 1); DMA_K(2, 2); DMA_V(0, 0);
    bf16x8 qf[4];
    { const bf16* qp = Q + (size_t)(seq0 + qb * 128 + wq * 32 + r32) * 1024 + h * 128 + comp * 64 + hi * 8;
#pragma unroll
      for (int s = 0; s < 4; ++s) qf[s] = *(const bf16x8*)(qp + s * 16); }
    const int sw = (r32 >> 1) & 7; const LAS unsigned char* kbs[4]; const LAS unsigned char* vbs[4];
#pragma unroll
    for (int s = 0; s < 4; ++s) { const int fo = r32 * 128 + (((2 * s + hi) ^ sw) << 4); kbs[s] = lds + KRING + comp * 8192 + fo; vbs[s] = lds + VRING + fo; }
#pragma unroll
    for (int d = 0; d < 4; ++d)
#pragma unroll
        for (int r = 0; r < 16; ++r) o[d][r] = 0.f;
    float m_run = 0.f, alpha = 1.f; bool resc = false; const float thr_ = THR;
    f32x16 pA, pB, pC, pD;
    f32x16 negm;
    v4u pw[4];
    bf16x8 kf[8];
#define SBAR() __builtin_amdgcn_sched_barrier(0)
#define PIN(x) asm volatile("" : "+v"(x))
#define USE(x) asm volatile("" :: "v"(x))
#define SGB(mask, n) __builtin_amdgcn_sched_group_barrier((mask), (n), 0)
#define KFR(kh, s) (*(const LAS bf16x8*)(kbs[s] + (kb_ + (kh) * 4096)))
#define VFR(d, s) (*(const LAS bf16x8*)(vbs[s] + (vb_ + (d) * 4096)))
#define MFMA32(a, b, c) __builtin_amdgcn_mfma_f32_32x32x16_bf16((a), (b), (c), 0, 0, 0)
#define GAPA(C, CIN, kh, s, P, B, W) do { C = MFMA32(kf[(s) * 2 + (kh)], qf[s], CIN); PIN(C); \
        pw[W][((B) >> 1) & 3] = cvt_pk_bf16(P[B], P[B + 1]); pw[W][(((B) >> 1) & 3) + 1] = cvt_pk_bf16(P[B + 2], P[B + 3]); \
        l_run += P[B]; l_run += P[B + 1]; l_run += P[B + 2]; l_run += P[B + 3]; USE(l_run); SBAR(); } while (0)
#define PVM(d, s) o[d] = MFMA32(vf[((d) & 1) * 4 + (s)], __builtin_bit_cast(bf16x8, pw[s]), o[d])
#define MAXF(X, B) "v"(X[B]), "v"(X[B + 1]), "v"(X[B + 2]), "v"(X[B + 3]), "v"(X[B + 4]), "v"(X[B + 5]), "v"(X[B + 6]), "v"(X[B + 7])
#define GAPM_FIRST(d, s, X, B) do { PVM(d, s); asm("v_max3_f32 %0, %2, %3, %4\n\tv_max3_f32 %1, %5, %6, %7\n\tv_max3_f32 %0, %0, %8, %9" : "=&v"(mxa), "=&v"(mxb) : MAXF(X, B)); SBAR(); } while (0)
#define GAPM(d, s, X, B) do { PVM(d, s); asm("v_max3_f32 %0, %0, %2, %3\n\tv_max3_f32 %1, %1, %4, %5\n\tv_max3_f32 %0, %0, %6, %7\n\tv_max3_f32 %1, %1, %8, %9" : "+v"(mxa), "+v"(mxb) : MAXF(X, B)); SBAR(); } while (0)
#define GAPM_LAST(d, s, X, B) do { PVM(d, s); asm("v_max3_f32 %0, %0, %3, %4\n\tv_max3_f32 %1, %1, %5, %6\n\tv_max3_f32 %0, %0, %7, %8\n\tv_max3_f32 %1, %1, %9, %10\n\tv_max_f32 %0, %0, %1\n\tv_cmp_nle_f32 %2, %0, %11" \
        : "+v"(mxa), "+v"(mxb), "=s"(over) : MAXF(X, B), "s"(thr_)); SBAR(); } while (0)
#define GAPE3(d, s, X, B) do { PVM(d, s); X[B] = __builtin_amdgcn_exp2f(X[B]); X[B + 1] = __builtin_amdgcn_exp2f(X[B + 1]); X[B + 2] = __builtin_amdgcn_exp2f(X[B + 2]); PIN(X); SBAR(); } while (0)
#define GAPE2(d, s, X, B) do { PVM(d, s); X[B] = __builtin_amdgcn_exp2f(X[B]); X[B + 1] = __builtin_amdgcn_exp2f(X[B + 1]); PIN(X); SBAR(); } while (0)
#define DECIDE(C0, C1) do { resc = false; \
        if (__builtin_expect(over != 0ull, 0)) { const float mx = swapf_max(mxa); const float dl = fmaxf(mx, 0.f); alpha = __builtin_amdgcn_exp2f(-dl); m_run += dl; l_run *= alpha; resc = true; \
            _Pragma("unroll") for (int r = 0; r < 16; ++r) { C0[r] -= dl; C1[r] -= dl; negm[r] -= dl; } } } while (0)
#define RESCALE() do { if (resc) { _Pragma("unroll") for (int d = 0; d < 4; ++d) _Pragma("unroll") for (int r = 0; r < 16; ++r) o[d][r] *= alpha; } } while (0)
#define KPRE2(kslot, s0) do { constexpr int kb_ = (kslot) * 16384; _Pragma("unroll") for (int s = (s0); s < (s0) + 2; ++s) { kf[2 * s] = KFR(0, s); kf[2 * s + 1] = KFR(1, s); } } while (0)
#define PHASE_A(C0, C1, P0, P1, vslot) do { \
        constexpr int vb_ = (vslot) * 16384; \
        SBAR(); \
        GAPA(C0, negm, 0, 0, P0, 0, 0); GAPA(C1, negm, 1, 0, P0, 4, 0); \
        GAPA(C0, C0, 0, 1, P0, 8, 1); GAPA(C1, C1, 1, 1, P0, 12, 1); \
        GAPA(C0, C0, 0, 2, P1, 0, 2); GAPA(C1, C1, 1, 2, P1, 4, 2); \
        _Pragma("unroll") for (int s = 0; s < 4; ++s) vf[s] = VFR(0, s); SBAR();        \
        GAPA(C0, C0, 0, 3, P1, 8, 3); GAPA(C1, C1, 1, 3, P1, 12, 3); \
        } while (0)
#define PHASE_B(C0, C1, vslot, knext, pre) do { \
        constexpr int vb_ = (vslot) * 16384; \
        _Pragma("unroll") for (int s = 0; s < 4; ++s) vf[4 + s] = VFR(1, s); \
        float mxa, mxb; unsigned long long over; asm volatile("s_nop 15\n\ts_nop 7" : "+v"(C0), "+v"(C1)); SBAR(); \
        GAPM_FIRST(0, 0, C0, 0); GAPM(0, 1, C0, 8); GAPM(0, 2, C1, 0); GAPM_LAST(0, 3, C1, 8); \
        DECIDE(C0, C1); \
        _Pragma("unroll") for (int s = 0; s < 4; ++s) vf[s] = VFR(2, s); SBAR(); \
        GAPE3(1, 0, C0, 0); GAPE3(1, 1, C0, 3); GAPE3(1, 2, C0, 6); GAPE3(1, 3, C0, 9); \
        _Pragma("unroll") for (int s = 0; s < 4; ++s) vf[4 + s] = VFR(3, s); if (pre) KPRE2(knext, 0); SBAR(); \
        GAPE3(2, 0, C0, 12); C0[15] = __builtin_amdgcn_exp2f(C0[15]); GAPE3(2, 1, C1, 0); if (pre) KPRE2(knext, 2); SBAR(); GAPE3(2, 2, C1, 3); GAPE3(2, 3, C1, 6); \
        GAPE3(3, 0, C1, 9); GAPE2(3, 1, C1, 12); GAPE2(3, 2, C1, 14); PVM(3, 3); SBAR(); \
        RESCALE(); } while (0)
#define BOUNDARY(t, S0, SN) do { if ((t) + 2 < NT) WAIT_BAR_N(4); else WAIT_BAR_N(2); \
        if ((t) + 3 < NT) DMA_K((t) + 3, S0); if ((t) + 1 < NT) DMA_V((t) + 1, SN); } while (0)
#define STEP(C0, C1, P0, P1, t, S0, S1, SN) do { BOUNDARY((t), S0, SN); bf16x8 vf[8]; PHASE_A(C0, C1, P0, P1, S1); PHASE_B(C0, C1, S1, SN, ((t) + 1 < NT)); } while (0)
    WAIT_BAR();
    KPRE2(0, 0); KPRE2(0, 2);
    WAIT_BAR_N(0);
    DMA_K(3, 0); DMA_V(1, 1);
    {
#pragma unroll
      for (int r = 0; r < 16; ++r) { pA[r] = 0.f; pB[r] = 0.f; }
#pragma unroll
      for (int s = 0; s < 4; ++s) { pA = MFMA32(kf[2 * s], qf[s], pA); pB = MFMA32(kf[2 * s + 1], qf[s], pB); }
      SBAR(); KPRE2(1, 0); KPRE2(1, 2);
      float mx = fmaxf(pA[0], pB[0]);
#pragma unroll
      for (int r = 1; r < 16; ++r) mx = fmaxf(mx, fmaxf(pA[r], pB[r]));
      m_run = swapf_max(mx);
#pragma unroll
      for (int r = 0; r < 16; ++r) { pA[r] = __builtin_amdgcn_exp2f(pA[r] - m_run); pB[r] = __builtin_amdgcn_exp2f(pB[r] - m_run); negm[r] = -m_run; } }
    if (comp == 1) __builtin_amdgcn_s_setprio(1);
    int t = 1;
    for (; t + 6 < NT; t += 6) {
        STEP(pC, pD, pA, pB, t, 1, 0, 2); STEP(pA, pB, pC, pD, t + 1, 2, 1, 0); STEP(pC, pD, pA, pB, t + 2, 0, 2, 1);
        STEP(pA, pB, pC, pD, t + 3, 1, 0, 2); STEP(pC, pD, pA, pB, t + 4, 2, 1, 0); STEP(pA, pB, pC, pD, t + 5, 0, 2, 1); }
    if (NT == 64) { STEP(pC, pD, pA, pB, 61, 1, 0, 2); STEP(pA, pB, pC, pD, 62, 2, 1, 0); STEP(pC, pD, pA, pB, 63, 0, 2, 1); }
    else { STEP(pC, pD, pA, pB, 31, 1, 0, 2); }
    __builtin_amdgcn_s_setprio(0);
    WAIT_BAR();
    const int vs_last = (NT == 64) ? 0 : 1;
    { const int vb_ = vs_last * 16384;
      float sacc = 0.f;
#pragma unroll
      for (int r = 0; r < 16; ++r) sacc += pC[r] + pD[r];
      l_run += sacc;
      bf16x8 pa[4]; pa[0] = pack_p(pC, 0); pa[1] = pack_p(pC, 1); pa[2] = pack_p(pD, 0); pa[3] = pack_p(pD, 1);
#pragma unroll
      for (int d = 0; d < 4; ++d)
#pragma unroll
          for (int s = 0; s < 4; ++s) o[d] = __builtin_amdgcn_mfma_f32_32x32x16_bf16(VFR(d, s), pa[s], o[d], 0, 0, 0); }
#undef DMA_K
#undef DMA_V
#undef STEP
#undef BOUNDARY
#undef PHASE_A
#undef PHASE_B
#undef KPRE2
#undef GAPA
#undef GAPM
#undef MAXF
#undef GAPM_FIRST
#undef GAPM_LAST
#undef GAPE3
#undef GAPE2
#undef PVM
#undef DECIDE
#undef RESCALE
#undef PIN
#undef USE
#undef SGB
#undef KFR
#undef VFR
    }
    WAIT_BAR();
    FRESH_TID(te_);
#undef FRESH_TID
    const int tid = te_, lane = tid & 63, r32 = lane & 31, hi = lane >> 5;
    const float inv = 1.f / swapf_add(l_run);
    LAS float* X = (LAS float*)(lds + XOFF); LAS float* Gt = (LAS float*)(lds + GOFF);
    if (comp == 1) { const float f = lam * inv;
#pragma unroll
        for (int d = 0; d < 4; ++d)
#pragma unroll
            for (int r = 0; r < 16; ++r) X[(wq * 128 + 32 * d + crow(r, hi)) * 32 + r32] = o[d][r] * f; }
    { int l_ = layer; asm volatile("" : "+s"(l_)); if (tid < 128) Gt[tid] = subg[tid] * (1.f - (0.8f - 0.6f * __expf(-0.3f * (float)l_))); }
    __syncthreads();
    if (comp == 0) {
        float ss = 0.f;
#pragma unroll
        for (int d = 0; d < 4; ++d)
#pragma unroll
            for (int r = 0; r < 16; ++r) { const float v = o[d][r] * inv - X[(wq * 128 + 32 * d + crow(r, hi)) * 32 + r32]; o[d][r] = v; ss += v * v; }
        ss = swapf_add(ss);
        const float rs = rsqrtf(ss * (1.f / 128.f) + RMS_EPS);
        LAS unsigned char* os = lds + OSOFF + wq * (32 * 272);
#pragma unroll
        for (int d = 0; d < 4; ++d)
#pragma unroll
            for (int rg = 0; rg < 4; ++rg) { const int d0 = 32 * d + 8 * rg + 4 * hi; const f32x4 gg = *(const LAS f32x4*)(Gt + d0);
                v2u w; w.x = cvt_pk_bf16(o[d][4 * rg] * rs * gg.x, o[d][4 * rg + 1] * rs * gg.y); w.y = cvt_pk_bf16(o[d][4 * rg + 2] * rs * gg.z, o[d][4 * rg + 3] * rs * gg.w);
                *(LAS v2u*)(os + r32 * 272 + d0 * 2) = w; }
        LDS_WAIT(); asm volatile("" ::: "memory");
        bf16* Ow = O + (size_t)(seq0 + qb * 128 + wq * 32) * DM + h * 128;
#pragma unroll
        for (int i = 0; i < 8; ++i) { const int cid = lane + 64 * i, row = cid >> 4, c16 = cid & 15; const v4u v = *(const LAS v4u*)(os + row * 272 + c16 * 16); *(v4u*)(Ow + (size_t)row * DM + c16 * 8) = v; }
    }
}
struct APtrs { const float *q1, *k1, *q2, *k2, *subln; };
__device__ __forceinline__ void attn_phase(Frame& F, const APtrs& A, int l) {
    const bf16* Q = (const bf16*)(F.ws + WS_Q); const bf16* K = (const bf16*)(F.ws + WS_K); const bf16* VT = (const bf16*)(F.ws + WS_VT); bf16* MIX = (bf16*)(F.ws + WS_HB);
    const float lam_init = 0.8f - 0.6f * expf(-0.3f * (float)l);
    float d1 = 0.f, d2 = 0.f;
    for (int i = 0; i < 64; ++i) { d1 += A.q1[l * 64 + i] * A.k1[l * 64 + i]; d2 += A.q2[l * 64 + i] * A.k2[l * 64 + i]; }
    const float lam = __builtin_bit_cast(float, __builtin_amdgcn_readfirstlane(__builtin_bit_cast(int, expf(d1) - expf(d2) + lam_init)));
    const float* subg = A.subln + l * 128;
    for (int U = F.vcu; U < 1024; U += F.G) { const int bh = U >> 5, qb = U & 31, b = bh >> 3, h = bh & 7; attn_unit(Q, K, VT, MIX, subg, lam, l, NPROMPT + b * 4096, 4096, h, qb, F.lds, F.wave); }
    for (int U = F.vcu; U < 2048; U += F.G) { const int bh = U >> 4, qb = U & 15, b = bh >> 3, h = bh & 7; attn_unit(Q, K, VT, MIX, subg, lam, l, b * 2048, 2048, h, qb, F.lds, F.wave); }
    __syncthreads();
}
}
#ifndef UP_ALIGN
#define UP_ALIGN true
#endif
#ifndef FFN_SP2
#define FFN_SP2 true
#endif
constexpr int NSSMW = NGRP * SSM_SPLIT;
constexpr int NSLAB = 6, SLAB_ROWS = NTOK / NSLAB  , SLAB_PANELS = SLAB_ROWS / 256;
constexpr int PH_PER_LAYER = 7 + NSLAB + 1, NPHASE = 1 + NLAYER * PH_PER_LAYER + 1;
struct Args { const float* in[26]; float* out; unsigned char* ws; int ph_lo, ph_hi, use_bar, pad; };
typedef __attribute__((address_space(4))) const unsigned char* KP;
template <class T> __device__ __forceinline__ T karg(KP kp, int off) { typedef T TT; return *(const __attribute__((address_space(4))) TT*)(kp + off); }
#define KARG(T, off) karg<T>(kp, (off))
__global__ void __launch_bounds__(NWAVES * 64, 2) fwd_kernel(Args args) {
    extern __shared__ __attribute__((aligned(16))) unsigned char lds_raw[];
    Frame F;
    F.lds = (LAS unsigned char*)lds_raw;
    F.tid = threadIdx.x; F.lane = F.tid & 63; F.wave = __builtin_amdgcn_readfirstlane(F.tid >> 6);
    F.G = gridDim.x; { const int bx = blockIdx.x; F.vcu = (F.G % 8 == 0) ? (bx % 8) * (F.G / 8) + bx / 8 : bx; }
    KP kp0 = (KP)__builtin_amdgcn_kernarg_segment_ptr();
    static_assert(sizeof(Args) == 240, "Args layout");
    F.out = nullptr; F.ws = nullptr;
    volatile LAS unsigned* MISC = (volatile LAS unsigned*)(F.lds + MISC_OFF);
    for (int u = F.tid; u < (LDS_BYTES - LDSCTL_OFF) / 4; u += NWAVES * 64) ((LAS unsigned*)(F.lds + LDSCTL_OFF))[u] = 0u;
    __syncthreads();
    KP kp = kp0; asm volatile("" : "+s"(kp));
    unsigned* barw = (unsigned*)(KARG(unsigned char*, 216) + WS_CTL) + CW_BAR;
    XcdBarrier bar; bar.bar = barw; bar.x = 0; bar.st = nullptr;
    if (KARG(int, 232)) bar = xcd_barrier_post(barw, MISC + 8);
    const int lo = KARG(int, 224), hi = KARG(int, 228);
#define IN(k) (lo <= (k) && (k) < hi)
#define SEAM(k) do { if (IN(k) && IN((k) + 1)) xcd_barrier(bar); } while (0)
#define PHASE_FRAME() Frame P; KP kp = kp0; { int g_ = __builtin_amdgcn_readfirstlane(F.G), v_ = __builtin_amdgcn_readfirstlane(F.vcu), w_ = F.wave, c_ = __builtin_amdgcn_readfirstlane((int)blockIdx.x); \
        asm volatile("" : "+s"(kp), "+s"(g_), "+s"(v_), "+s"(w_), "+s"(c_)); \
        unsigned z_ = 0u; asm volatile("" : "+v"(z_)); int t_ = w_ * 64 + (int)__builtin_amdgcn_mbcnt_hi(~0u, __builtin_amdgcn_mbcnt_lo(~0u, z_)); asm volatile("" : "+v"(t_)); \
        P.out = KARG(float*, 208); P.ws = KARG(unsigned char*, 216); P.G = g_; P.vcu = v_; P.tid = t_; P.lane = t_ & 63; P.wave = w_; P.lds = F.lds; cblk = c_; } \
        LAS unsigned char* ring = P.lds
#define AIN(k) KARG(const float*, 8 * (k))
#define WPTRS() WPtrs WP{AIN(3), AIN(21), AIN(17), AIN(19), AIN(20), AIN(23), AIN(24), AIN(2), AIN(22)}
#define SPTRS() SPtrs SS{AIN(9), AIN(10), AIN(11), AIN(12), AIN(13), AIN(14), AIN(15), AIN(16)}
#define WSP(T, off) ((T*)(P.ws + (off)))
#define SS1(l) (WSP(unsigned long long, WS_SS) + (size_t)(l) * NTOK)
#define SS2(l) (WSP(unsigned long long, WS_SS) + (size_t)(5 + (l)) * NTOK)
#define X1P ((bf16*)P.out)
#define X2P ((bf16*)P.out + (size_t)NTOK * DM)
    int cblk = 0;
    if (IN(0)) { PHASE_FRAME(); (void)ring; WPTRS(); SPTRS();
        if (P.G >= 2 * NSSMW) { if (cblk >= NSSMW) convert_weights(P, WP, 0, 7, cblk - NSSMW, P.G - NSSMW); else ssm_weights(P, SS, 0); __syncthreads(); }
        else { convert_weights(P, WP, 0, 7, cblk, P.G); __syncthreads(); ssm_weights(P, SS, 0); }
        input_rows(P, AIN(0), AIN(1), X1P, SS1(0));
        SEAM(0);
    }
    for (int l = 0; l < NLAYER; ++l) {
        const int pb = 1 + l * PH_PER_LAYER;
        if (IN(pb + 0)) { PHASE_FRAME();
            if (l > 0) { WPTRS(); convert_weights(P, WP, l, 2, cblk, P.G); __syncthreads(); }
            { pg8::Gemm g{X1P, WSP(bf16, WS_WIN), NTOK, 3072, DM}; pg8::SchedX<1> S; S.init(NTOK, 3072, P.G, cblk); S.off = 0;
              pg8::EpiInProj E{WSP(bf16, WS_Q), WSP(bf16, WS_K), WSP(bf16, WS_US), WSP(bf16, WS_UP), WSP(const float, WS_ROPE), SS1(l)};
              pg8::gemm_phase<pg8::EpiInProj, pg8::SchedX<1>, true, true>(ring, g, S, E, P.tid); }
            { pg8::Gemm g{WSP(bf16, WS_WIN) + (size_t)2048 * DM, X1P, 1024, NTOK, DM}; pg8::SchedX<0> S; S.init(1024, NTOK, P.G, cblk); S.off = 0;
              pg8::EpiVT E{WSP(bf16, WS_VT), SS1(l)};
              pg8::gemm_phase<pg8::EpiVT, pg8::SchedX<0>, true, true>(ring, g, S, E, P.tid); }
            SEAM(pb + 0);
        }
        if (IN(pb + 1)) { PHASE_FRAME(); int kssm = 256; asm volatile("" : "+s"(kssm));
            { pg8::Gemm g{WSP(bf16, WS_US), WSP(bf16, WS_SSM1), NGRP * NCHUNK, 512, kssm}; pg8::SchedX<2> S; S.init(NGRP * NCHUNK, 512, P.G, cblk); S.off = 0;
              pg8::EpiSsm1 E{WSP(bf16, WS_YI), (size_t)(WS_Z - WS_YI) / 2};
              pg8::gemm_phase<pg8::EpiSsm1, pg8::SchedX<2>, true, true>(ring, g, S, E, P.tid); }
            SEAM(pb + 1);
        }
        if (IN(pb + 2)) { PHASE_FRAME(); (void)ring; ssm_scan(P); pool_prepass(P); SEAM(pb + 2); }
        if (IN(pb + 3)) { PHASE_FRAME(); int kssm = 256; asm volatile("" : "+s"(kssm));
            { pg8::Gemm g{WSP(bf16, WS_SP), WSP(bf16, WS_SSM2), NGRP * NCHUNK, 256, kssm}; pg8::SchedX<3> S; S.init(NGRP * NCHUNK, 256, P.G, cblk); S.off = 0;
              pg8::EpiSsm2 E{WSP(bf16, WS_YI), WSP(bf16, WS_ZB)};
              pg8::gemm_phase<pg8::EpiSsm2, pg8::SchedX<3>, true, true>(ring, g, S, E, P.tid); }
            SEAM(pb + 3);
        }
        if (IN(pb + 4)) { PHASE_FRAME();
            { pg8::Gemm g{WSP(bf16, WS_ZB), WSP(bf16, WS_GP), 2 * NTOK, 1024, 512}; pg8::SchedX<4> S; S.init(NTOK, 1024, P.G, cblk); S.off = 0;
              pg8::EpiGluPool E{WSP(bf16, WS_ZB), AIN(18) + (size_t)l * 512, WSP(bf16, WS_HB)};
              pg8::gemm_phase<pg8::EpiGluPool, pg8::SchedX<4>, true, true>(ring, g, S, E, P.tid); }
            if (!IN(pb + 5)) SEAM(pb + 4);
        }
        if (IN(pb + 5)) { PHASE_FRAME(); (void)ring; att::APtrs AP{AIN(4), AIN(5), AIN(6), AIN(7), AIN(8)}; att::attn_phase(P, AP, l); SEAM(pb + 5); }
        if (IN(pb + 6)) { PHASE_FRAME();
            { pg8::Gemm g{WSP(bf16, WS_HB), WSP(bf16, WS_WOUT), NTOK, DM, DM}; pg8::SchedX<0> S; S.init(NTOK, DM, P.G, cblk); S.off = 0;
              pg8::EpiResidX E{X1P, X2P, SS2(l), 0};
              pg8::gemm_phase<pg8::EpiResidX, pg8::SchedX<0>, true, true>(ring, g, S, E, P.tid); }
            SEAM(pb + 6);
        }
        for (int s = 0; s <= NSLAB; ++s) {
            if (IN(pb + 7 + s)) { PHASE_FRAME();
                if (s == 0 && l + 1 < NLAYER) { WPTRS(); SPTRS();
                    if (P.G >= 2 * NSSMW) { if (cblk >= NSSMW) convert_weights(P, WP, l + 1, 1, cblk - NSSMW, P.G - NSSMW); else ssm_weights(P, SS, l + 1); __syncthreads(); }
                    else { convert_weights(P, WP, l + 1, 1, cblk, P.G); __syncthreads(); ssm_weights(P, SS, l + 1); __syncthreads(); } }
                const int par = 0;
#pragma unroll 1
                for (int k = 0; k < 2; ++k) { int kk = k ^ par; asm volatile("" : "+s"(kk));
                    if (kk == 0) { if (s > 0) { const int sd = s - 1;
                        pg8::Gemm g{WSP(bf16, WS_HID) + (size_t)(sd & 1) * ((size_t)SLAB_ROWS * DFF), WSP(bf16, WS_WDN), SLAB_ROWS, DM, DFF}; pg8::SchedX<0> S; S.init(SLAB_ROWS, DM, P.G, cblk); S.off = 0;
                        pg8::EpiResidX E{X2P, l + 1 < NLAYER ? X1P : WSP(bf16, WS_HB), SS1(l + 1), sd * SLAB_ROWS};
                        pg8::gemm_phase<pg8::EpiResidX, pg8::SchedX<0>, true, FFN_SP2>(ring, g, S, E, P.tid); } }
                    else { if (s < NSLAB) {
                        pg8::Gemm g{X2P, WSP(bf16, WS_WUP), NTOK, DFF, DM}; pg8::SchedX<0> S; S.init(SLAB_ROWS, DFF, P.G, cblk); S.off = s * SLAB_PANELS;
                        pg8::EpiSqRelu E{WSP(bf16, WS_HID) + (size_t)(s & 1) * ((size_t)SLAB_ROWS * DFF), s * SLAB_ROWS, SS2(l)};
                        pg8::gemm_phase<pg8::EpiSqRelu, pg8::SchedX<0>, UP_ALIGN, FFN_SP2>(ring, g, S, E, P.tid); } }
                }
                SEAM(pb + 7 + s);
            }
        }
    }
    if (IN(NPHASE - 1)) { PHASE_FRAME(); (void)ring; final_norm(P, WSP(bf16, WS_HB), AIN(25), SS1(NLAYER)); }
#undef IN
#undef SEAM
}

#ifndef MK_ONE_LAUNCH
#define MK_ONE_LAUNCH 1
#endif
extern "C" void kernel_launch(void* const* d_in, const int* in_sizes, int n_in, void* d_out, int out_size, void* d_ws, size_t ws_size, hipStream_t stream) {
    static int grid = 0;
    if (grid == 0) {
        if (n_in != 26 || out_size != NTOK * DM || ws_size < WS_END) { fprintf(stderr, "kernel_launch: unexpected shapes: n_in %d out %d ws %zu (need %zu)\n", n_in, out_size, ws_size, (size_t)WS_END); grid = -1; return; }
        int dev = 0, cus = 0, per_cu = 0;
        if (hipGetDevice(&dev) != hipSuccess || hipDeviceGetAttribute(&cus, hipDeviceAttributeMultiprocessorCount, dev) != hipSuccess) { grid = -1; return; }
        if (hipFuncSetAttribute((const void*)fwd_kernel, hipFuncAttributeMaxDynamicSharedMemorySize, LDS_BYTES) != hipSuccess) { fprintf(stderr, "kernel_launch: hipFuncSetAttribute failed\n"); grid = -1; return; }
        if (hipOccupancyMaxActiveBlocksPerMultiprocessor(&per_cu, (const void*)fwd_kernel, NWAVES * 64, LDS_BYTES) != hipSuccess || per_cu < 1) fprintf(stderr, "kernel_launch: occupancy query reports %d\n", per_cu);
        (void)hipGetLastError();
        grid = cus;
    }
    if (grid < 0) return;
    if (hipMemsetAsync((char*)d_ws + WS_CTL, 0, CTL_ZERO_BYTES, stream) != hipSuccess) return;
    if (hipMemsetAsync((char*)d_ws + WS_SS, 0, SS_BYTES, stream) != hipSuccess) return;
    Args a{};
    for (int i = 0; i < 26; ++i) a.in[i] = (const float*)d_in[i];
    a.out = (float*)d_out; a.ws = (unsigned char*)d_ws; a.pad = 0;
#if MK_ONE_LAUNCH
    a.ph_lo = 0; a.ph_hi = NPHASE; a.use_bar = 1;
    hipLaunchKernelGGL(fwd_kernel, dim3(grid), dim3(NWAVES * 64), LDS_BYTES, stream, a);
#else
    a.use_bar = 0;
    for (int p = 0; p < NPHASE; ++p) { a.ph_lo = p; a.ph_hi = p + 1; hipLaunchKernelGGL(fwd_kernel, dim3(grid), dim3(NWAVES * 64), LDS_BYTES, stream, a); }
#endif
    const hipError_t le = hipPeekAtLastError();
    if (le != hipSuccess) fprintf(stderr, "kernel_launch: launch failed: %s\n", hipGetErrorName(le));
}
```
